# Optimizing an MI355X kernel written in HIP

```python
import jax, jax.numpy as jnp
from jax import lax
import numpy as np

D_MODEL = 2048
BATCH = 1
SEQ = 8192
DEPTH = 1

EPS = 1e-6
Q_BLOCK = 128
NEG = -1e30

MLA_HEADS = 8
MLA_Q_RANK = 512
MLA_KV_RANK = 256
MLA_NOPE = 128
MLA_ROPE = 64
MLA_V = 128
ROPE_THETA = 10000.0

NSA_HEADS = 16
NSA_KV_GROUPS = 2
NSA_HPG = NSA_HEADS // NSA_KV_GROUPS
NSA_DK = 64
NSA_DV = 64
CMP_LEN = 32
CMP_STRIDE = 16
CMP_HIDDEN = 256
SEL_LEN = 64
SEL_TOPK = 16
WINDOW = 512
FORCE_BONUS = 1e4
NSA_KV_WIDTH = NSA_KV_GROUPS * (NSA_DK + NSA_DV)

MIX_WIDTH = MLA_HEADS * MLA_V + NSA_HEADS * NSA_DV
MLP_HIDDEN = 4 * D_MODEL

IN_SIZES = (MLA_Q_RANK, MLA_KV_RANK, MLA_ROPE, NSA_HEADS * NSA_DK,
            NSA_KV_WIDTH, NSA_KV_WIDTH, NSA_KV_WIDTH, 3 * NSA_HEADS)
IN_WIDTH = sum(IN_SIZES)

kernel_name = "hybrid_mla_nsa_block"


def rmsnorm(x, w):
    xf = x.astype(jnp.float32)
    y = xf * lax.rsqrt(jnp.mean(xf * xf, axis=-1, keepdims=True) + EPS)
    return (y * w.astype(jnp.float32)).astype(x.dtype)


def _split_cols(t, sizes):
    offs = np.cumsum(sizes)[:-1].tolist()
    return jnp.split(t, offs, axis=-1)


def rope_cos_sin(positions, dim):
    inv = 1.0 / (ROPE_THETA ** (jnp.arange(0, dim, 2, dtype=jnp.float32) / dim))
    ang = positions.astype(jnp.float32)[..., None] * inv
    return jnp.cos(ang), jnp.sin(ang)


def apply_rope(x, cos, sin):
    xf = x.astype(jnp.float32)
    half = xf.shape[-1] // 2
    x1, x2 = xf[..., :half], xf[..., half:]
    return jnp.concatenate([x1 * cos - x2 * sin, x2 * cos + x1 * sin], axis=-1).astype(x.dtype)


def alibi_slopes(n):
    start = 2.0 ** (-8.0 / n)
    return start ** jnp.arange(1, n + 1, dtype=jnp.float32)


def masked_softmax(s, mask):
    p = jax.nn.softmax(jnp.where(mask, s, NEG), axis=-1)
    return jnp.where(mask, p, 0.0)


def mla_attention(c_q, c_kv, k_rope, positions, q_norm_w, w_uq, kv_norm_w, w_ukv):
    B, T, _ = c_q.shape
    q = (rmsnorm(c_q, q_norm_w) @ w_uq).reshape(B, T, MLA_HEADS, MLA_NOPE + MLA_ROPE)
    q_nope, q_pe = q[..., :MLA_NOPE], q[..., MLA_NOPE:]
    kv = (rmsnorm(c_kv, kv_norm_w) @ w_ukv).reshape(B, T, MLA_HEADS, MLA_NOPE + MLA_V)
    k_nope, v = kv[..., :MLA_NOPE], kv[..., MLA_NOPE:]
    cos, sin = rope_cos_sin(positions, MLA_ROPE)
    q_pe = apply_rope(q_pe, cos[:, :, None], sin[:, :, None])
    k_pe = apply_rope(k_rope, cos, sin)
    scale = (MLA_NOPE + MLA_ROPE) ** -0.5
    nb = T // Q_BLOCK
    qn_b = jnp.moveaxis(q_nope.reshape(B, nb, Q_BLOCK, MLA_HEADS, MLA_NOPE), 1, 0)
    qp_b = jnp.moveaxis(q_pe.reshape(B, nb, Q_BLOCK, MLA_HEADS, MLA_ROPE), 1, 0)
    kpos = jnp.arange(T)

    def block(args):
        i, qn, qp = args
        s = (jnp.einsum('bqhd,bkhd->bhqk', qn, k_nope)
             + jnp.einsum('bqhd,bkd->bhqk', qp, k_pe)).astype(jnp.float32) * scale
        qpos = i * Q_BLOCK + jnp.arange(Q_BLOCK)
        p = masked_softmax(s, kpos[None, :] <= qpos[:, None])
        return jnp.einsum('bhqk,bkhd->bqhd', p.astype(v.dtype), v)

    out = lax.map(block, (jnp.arange(nb), qn_b, qp_b))
    return jnp.moveaxis(out, 0, 1).reshape(B, T, MLA_HEADS * MLA_V)


def nsa_attention(q, kv_cmp, kv_slc, kv_win, gate_logits,
                  cmp_pos_k, cmp_pos_v, cmp_w1_k, cmp_w2_k, cmp_w1_v, cmp_w2_v):
    B, T, _ = q.shape
    G, HG = NSA_KV_GROUPS, NSA_HPG
    q = q.reshape(B, T, G, HG, NSA_DK)
    gates = jax.nn.sigmoid(gate_logits.astype(jnp.float32)).reshape(B, T, G, HG, 3).astype(q.dtype)

    def kv_split(kv):
        kv = kv.reshape(B, T, G, NSA_DK + NSA_DV)
        return kv[..., :NSA_DK], kv[..., NSA_DK:]

    k_c, v_c = kv_split(kv_cmp)
    k_s, v_s = kv_split(kv_slc)
    k_w, v_w = kv_split(kv_win)

    n_cmp = (T - CMP_LEN) // CMP_STRIDE + 1
    cmp_start = jnp.arange(n_cmp) * CMP_STRIDE
    cmp_end = cmp_start + CMP_LEN - 1
    tok_idx = cmp_start[:, None] + jnp.arange(CMP_LEN)[None, :]

    def compress(t, pos, w1, w2):
        blk = t[:, tok_idx] + pos[None, None, :, None, :]
        blk = blk.transpose(0, 1, 3, 2, 4).reshape(B, n_cmp, G, CMP_LEN * t.shape[-1])
        return jax.nn.gelu(blk @ w1) @ w2

    k_cmp = compress(k_c, cmp_pos_k, cmp_w1_k, cmp_w2_k)
    v_cmp = compress(v_c, cmp_pos_v, cmp_w1_v, cmp_w2_v)

    n_sel = T // SEL_LEN
    top_k = min(SEL_TOPK, n_sel)
    sel_start = jnp.arange(n_sel) * SEL_LEN
    overlap = ((cmp_start[:, None] <= sel_start[None, :] + SEL_LEN - 1)
               & (cmp_end[:, None] >= sel_start[None, :])).astype(jnp.float32)
    slopes = alibi_slopes(NSA_HEADS).reshape(G, HG)[None, :, :, None, None]
    k_s_g = k_s.transpose(0, 2, 1, 3)
    v_s_g = v_s.transpose(0, 2, 1, 3)
    k_w_pad = jnp.pad(k_w, ((0, 0), (WINDOW, 0), (0, 0), (0, 0)))
    v_w_pad = jnp.pad(v_w, ((0, 0), (WINDOW, 0), (0, 0), (0, 0)))
    scale = NSA_DK ** -0.5
    gather = jax.vmap(jax.vmap(lambda src, idx: src[idx]))
    blk_ids = jnp.arange(n_sel)

    nb = T // Q_BLOCK
    q_b = jnp.moveaxis(q.reshape(B, nb, Q_BLOCK, G, HG, NSA_DK), 1, 0)
    g_b = jnp.moveaxis(gates.reshape(B, nb, Q_BLOCK, G, HG, 3), 1, 0)

    def block(args):
        i, qb, gb = args
        qpos = i * Q_BLOCK + jnp.arange(Q_BLOCK)
        s = jnp.einsum('bqghd,bngd->bghqn', qb, k_cmp).astype(jnp.float32) * scale
        dist = qpos[:, None] - cmp_end[None, :]
        s = s - slopes * dist.astype(jnp.float32)
        p_c = masked_softmax(s, dist >= 0)
        o_c = jnp.einsum('bghqn,bngd->bqghd', p_c.astype(v_cmp.dtype), v_cmp)
        imp = jnp.einsum('bghqn,ns->bgqs', p_c, overlap)
        cur = qpos // SEL_LEN
        forced = ((blk_ids[None, :] == 0) | (blk_ids[None, :] == cur[:, None])
                  | (blk_ids[None, :] == cur[:, None] - 1)).astype(jnp.float32)
        score = jnp.where(blk_ids[None, :] <= cur[:, None], imp + FORCE_BONUS * forced, NEG)
        top_val, top_idx = lax.top_k(score, top_k)
        tok = (top_idx[..., None] * SEL_LEN + jnp.arange(SEL_LEN)).reshape(B, G, Q_BLOCK, top_k * SEL_LEN)
        blk_ok = jnp.repeat(top_val > NEG * 0.5, SEL_LEN, axis=-1)
        k_sel = gather(k_s_g, tok)
        v_sel = gather(v_s_g, tok)
        s = jnp.einsum('bqghd,bgqmd->bghqm', qb, k_sel).astype(jnp.float32) * scale
        dist = qpos[None, None, :, None] - tok
        s = s - slopes * dist[:, :, None].astype(jnp.float32)
        p_s = masked_softmax(s, ((dist >= 0) & blk_ok)[:, :, None])
        o_s = jnp.einsum('bghqm,bgqmd->bqghd', p_s.astype(v_sel.dtype), v_sel)
        kw = lax.dynamic_slice_in_dim(k_w_pad, i * Q_BLOCK, WINDOW + Q_BLOCK, axis=1)
        vw = lax.dynamic_slice_in_dim(v_w_pad, i * Q_BLOCK, WINDOW + Q_BLOCK, axis=1)
        kpos = i * Q_BLOCK - WINDOW + jnp.arange(WINDOW + Q_BLOCK)
        dist = qpos[:, None] - kpos[None, :]
        mask = (dist >= 0) & (dist < WINDOW) & (kpos[None, :] >= 0)
        s = jnp.einsum('bqghd,bkgd->bghqk', qb, kw).astype(jnp.float32) * scale
        s = s - slopes * dist.astype(jnp.float32)
        p_w = masked_softmax(s, mask)
        o_w = jnp.einsum('bghqk,bkgd->bqghd', p_w.astype(vw.dtype), vw)
        return gb[..., 0:1] * o_c + gb[..., 1:2] * o_s + gb[..., 2:3] * o_w

    out = lax.map(block, (jnp.arange(nb), q_b, g_b))
    return jnp.moveaxis(out, 0, 1).reshape(B, T, NSA_HEADS * NSA_DV)


def setup_inputs(seed: int = 0) -> dict:
    key = jax.random.key(seed)
    ks = jax.random.split(key, 24)
    f32 = jnp.float32

    def w(k, shape, fan_in):
        return jax.random.normal(k, shape, f32) * (fan_in ** -0.5)

    def gain(k, shape):
        return 1.0 + 0.02 * jax.random.normal(k, shape, f32)

    L = DEPTH
    return {
        "x": jax.random.normal(ks[0], (BATCH, SEQ, D_MODEL), f32),
        "positions": jnp.broadcast_to(jnp.arange(SEQ, dtype=jnp.int32), (BATCH, SEQ)),
        "attn_norm_w": gain(ks[1], (L, D_MODEL)),
        "w_in": w(ks[2], (L, D_MODEL, IN_WIDTH), D_MODEL),
        "mla_q_norm_w": gain(ks[3], (L, MLA_Q_RANK)),
        "mla_w_uq": w(ks[4], (L, MLA_Q_RANK, MLA_HEADS * (MLA_NOPE + MLA_ROPE)), MLA_Q_RANK),
        "mla_kv_norm_w": gain(ks[5], (L, MLA_KV_RANK)),
        "mla_w_ukv": w(ks[6], (L, MLA_KV_RANK, MLA_HEADS * (MLA_NOPE + MLA_V)), MLA_KV_RANK),
        "cmp_pos_k": 0.1 * jax.random.normal(ks[7], (L, CMP_LEN, NSA_DK), f32),
        "cmp_pos_v": 0.1 * jax.random.normal(ks[8], (L, CMP_LEN, NSA_DV), f32),
        "cmp_w1_k": w(ks[9], (L, CMP_LEN * NSA_DK, CMP_HIDDEN), CMP_LEN * NSA_DK),
        "cmp_w2_k": w(ks[10], (L, CMP_HIDDEN, NSA_DK), CMP_HIDDEN),
        "cmp_w1_v": w(ks[11], (L, CMP_LEN * NSA_DV, CMP_HIDDEN), CMP_LEN * NSA_DV),
        "cmp_w2_v": w(ks[12], (L, CMP_HIDDEN, NSA_DV), CMP_HIDDEN),
        "mla_out_norm_w": gain(ks[13], (L, MLA_HEADS * MLA_V)),
        "nsa_out_norm_w": gain(ks[14], (L, NSA_HEADS * NSA_DV)),
        "w_o": w(ks[15], (L, MIX_WIDTH, D_MODEL), MIX_WIDTH),
        "mlp_norm_w": gain(ks[16], (L, D_MODEL)),
        "w_up": w(ks[17], (L, D_MODEL, MLP_HIDDEN), D_MODEL),
        "w_down": w(ks[18], (L, MLP_HIDDEN, D_MODEL), MLP_HIDDEN),
        "final_norm_w": gain(ks[19], (D_MODEL,)),
    }


def reference(x, positions, attn_norm_w, w_in, mla_q_norm_w, mla_w_uq, mla_kv_norm_w, mla_w_ukv,
              cmp_pos_k, cmp_pos_v, cmp_w1_k, cmp_w2_k, cmp_w1_v, cmp_w2_v,
              mla_out_norm_w, nsa_out_norm_w, w_o, mlp_norm_w, w_up, w_down, final_norm_w):
    h = x
    for l in range(DEPTH):
        n = rmsnorm(h, attn_norm_w[l])
        proj = n @ w_in[l]
        c_q, c_kv, k_rope, q_nsa, kv_cmp, kv_slc, kv_win, gate_logits = _split_cols(proj, IN_SIZES)
        y_mla = mla_attention(c_q, c_kv, k_rope, positions, mla_q_norm_w[l], mla_w_uq[l],
                              mla_kv_norm_w[l], mla_w_ukv[l])
        y_nsa = nsa_attention(q_nsa, kv_cmp, kv_slc, kv_win, gate_logits,
                              cmp_pos_k[l], cmp_pos_v[l], cmp_w1_k[l], cmp_w2_k[l],
                              cmp_w1_v[l], cmp_w2_v[l])
        y = jnp.concatenate([rmsnorm(y_mla, mla_out_norm_w[l]),
                             rmsnorm(y_nsa, nsa_out_norm_w[l])], axis=-1)
        h = h + y @ w_o[l]
        n = rmsnorm(h, mlp_norm_w[l])
        h = h + jnp.square(jax.nn.relu(n @ w_up[l])) @ w_down[l]
    return rmsnorm(h, final_norm_w)
```

```cpp
#include <hip/hip_runtime.h>
#include <hip/hip_cooperative_groups.h>
#include <cstdio>
#include <cstdint>
namespace cg = cooperative_groups;

#define DI __device__ __forceinline__
#define LAS __attribute__((address_space(3)))
typedef unsigned short bf16_t;
typedef short bf16x8 __attribute__((ext_vector_type(8)));
typedef short s16x4 __attribute__((ext_vector_type(4)));
typedef float f32x4 __attribute__((ext_vector_type(4)));
typedef float f32x16 __attribute__((ext_vector_type(16)));
typedef float f32x2 __attribute__((ext_vector_type(2)));
typedef unsigned u32x4 __attribute__((ext_vector_type(4)));
typedef unsigned u32x2 __attribute__((ext_vector_type(2)));
typedef __bf16 bf16x2_t __attribute__((ext_vector_type(2)));

constexpr int T = 8192, DM = 2048, INW = 2672, INWP = 2816, MLPH = 8192;
constexpr int MH = 8, QRANK = 512, KVRANK = 256, DQK = 192, MDV = 128;
constexpr int NG = 2, NHG = 8, NDK = 64;
constexpr float EPS = 1e-6f, LOG2E = 1.4426950408889634f;
constexpr float QS_MLA = 0.07216878364870322f * LOG2E;
constexpr float QS_NSA = 0.125f * LOG2E;
constexpr float NEGBIG = -1e30f;

constexpr size_t MiB = 1u << 20;
constexpr size_t WS_WDN = 0, WS_WUP = 32 * MiB, WS_WO = 64 * MiB, WS_WIN = 72 * MiB, WS_WUQ = 83 * MiB, WS_WUKV = 84 * MiB + 512 * 1024,
                 WS_W1K = 85 * MiB + 512 * 1024, WS_W1V = 86 * MiB + 512 * 1024;
constexpr size_t WS_XN = 88 * MiB;
constexpr size_t WS_CQ = 120 * MiB, WS_CKV = 128 * MiB, WS_KR = 132 * MiB, WS_QN = 134 * MiB, WS_KVC = 150 * MiB, WS_KVS = 154 * MiB,
                 WS_KVW = 158 * MiB, WS_GATE = 162 * MiB;
constexpr size_t WS_QM = 164 * MiB, WS_KM = 188 * MiB, WS_VM = 212 * MiB, WS_HIDK = 228 * MiB, WS_HIDV = 228 * MiB + 512 * 1024,
                 WS_KC = 229 * MiB, WS_VC = 229 * MiB + 128 * 1024;
constexpr size_t WS_U = 88 * MiB, WS_HB = 216 * MiB;
constexpr size_t WS_CTL = 248 * MiB, WS_COS = 249 * MiB, WS_SIN = 250 * MiB, WS_B1 = 251 * MiB, WS_SSQ2 = 252 * MiB, WS_SSQ3 = 253 * MiB,
                 WS_SSQQ = 254 * MiB, WS_SSQKV = 254 * MiB + 256 * 1024, WS_SSQM = 254 * MiB + 512 * 1024, WS_SSQN = 254 * MiB + 768 * 1024;
constexpr size_t WS_END = 256 * MiB;

constexpr int LDS_BYTES = 147456;

DI unsigned pk2(float lo, float hi) { f32x2 v = {lo, hi}; bf16x2_t b = __builtin_convertvector(v, bf16x2_t); return __builtin_bit_cast(unsigned, b); }
DI float bf2f(bf16_t b) { return __uint_as_float(((unsigned)b) << 16); }
DI u32x2 pk4(f32x4 v) { u32x2 r; r.x = pk2(v[0], v[1]); r.y = pk2(v[2], v[3]); return r; }
DI float wave_sum(float v) {
#pragma unroll
    for (int o = 1; o < 64; o <<= 1) v += __shfl_xor(v, o);
    return v;
}

namespace pg8 {
constexpr int BM = 256, BK = 64, HALF = 128, HTB = HALF * BK * 2, STAGE_BYTES = 8 * HTB;
DI int lds_byte(int r, int c) { const int st = (r >> 4) * 2 + (c >> 5), rr = r & 15, cc = c & 31, ob = rr * 64 + cc * 2; return st * 1024 + (ob ^ (((ob >> 9) & 1) << 5)); }
DI void stage_rc(int b, int& R, int& C) { const int st = b / 1024, sb = b % 1024, swz = sb ^ (((sb >> 9) & 1) << 5); R = (st >> 1) * 16 + swz / 64; C = (st & 1) * 32 + (swz % 64) / 2; }
struct Unit { int pm, pn, ko; };
struct Gemm { const bf16_t* A; const bf16_t* Bt; int lda, ldb, K; };

struct Order2 {
    int nM, ntot, G, c, kh;
    DI void init(int nM_, int nN_, int G_, int c_, int kh_) { nM = nM_; ntot = nM_ * nN_; G = G_; c = c_; kh = kh_; }
    DI bool next(int i, Unit& u) const { const int L = (i >> 1) * G + c; if (L >= ntot) return false; u.pm = L % nM; u.pn = L / nM; u.ko = (i & 1) * kh; return true; }
};
struct Order {
    int nM, ntot, G, c;
    DI void init(int nM_, int nN_, int G_, int c_) { nM = nM_; ntot = nM_ * nN_; G = G_; c = c_; }
    DI bool next(int i, Unit& u) const { const int L = i * G + c; if (L >= ntot) return false; u.pm = L % nM; u.pn = L / nM; u.ko = 0; return true; }
};

template <class Epi, class Sched>
DI void gemm_phase(LAS unsigned char* lds, const Gemm g, const Sched& S, const Epi& E) {
    int tid_ = threadIdx.x; asm volatile("" : "+v"(tid_));
    const int tid = tid_, wid = __builtin_amdgcn_readfirstlane(tid >> 6), lane = tid & 63, wr = wid >> 2, wc = wid & 3, fr = lane & 15, fq = lane >> 4;
    const int K = g.K, nt = K / BK;
    unsigned voffA[2], voffB[2];
#pragma unroll
    for (int i = 0; i < 2; ++i) { int R, C; stage_rc(tid * 16 + i * 8192, R, C);
        voffA[i] = (unsigned)(R * g.lda + C) * 2u; voffB[i] = (unsigned)(R * g.ldb + C) * 2u; }
    const size_t kstep = (size_t)(BK * 2);
    const size_t hstepA = (size_t)HALF * g.lda * 2, hstepB = (size_t)HALF * g.ldb * 2;
    const size_t tstepA = 2 * hstepA, tstepB = 2 * hstepB;
    const unsigned ldsw = (unsigned)wid * 1024u;
    const int aoff = lds_byte(wr * 64 + fr, fq * 8), boff = lds_byte(wc * 32 + fr, fq * 8);
#define PG8_SA(b, h) (((b) * 2 + (h)) * HTB)
#define PG8_SB(b, h) ((4 + (b) * 2 + (h)) * HTB)
#define PG8_STAGE(bufoff, gbase, voff) do { _Pragma("unroll") for (int _i = 0; _i < 2; ++_i) \
        __builtin_amdgcn_global_load_lds((const unsigned*)((const char*)(gbase) + (voff)[_i]), (LAS unsigned*)(lds + (bufoff) + ldsw + _i * 8192), 16, 0, 0); } while (0)
#define PG8_LDA(dst, b, h) do { _Pragma("unroll") for (int m = 0; m < 4; ++m) _Pragma("unroll") for (int k = 0; k < 2; ++k) dst[m][k] = *(const LAS bf16x8*)(lds + PG8_SA(b, h) + aoff + m * 2048 + k * 1024); } while (0)
#define PG8_LDB(dst, b, h) do { _Pragma("unroll") for (int n = 0; n < 2; ++n) _Pragma("unroll") for (int k = 0; k < 2; ++k) dst[n][k] = *(const LAS bf16x8*)(lds + PG8_SB(b, h) + boff + n * 2048 + k * 1024); } while (0)
#define PG8_MMA(ai, bj, At, Bt) do { __builtin_amdgcn_s_setprio(1); _Pragma("unroll") for (int m = 0; m < 4; ++m) _Pragma("unroll") for (int n = 0; n < 2; ++n) _Pragma("unroll") for (int k = 0; k < 2; ++k) \
        acc[ai][bj][m][n] = __builtin_amdgcn_mfma_f32_16x16x32_bf16(Bt[n][k], At[m][k], acc[ai][bj][m][n], 0, 0, 0); __builtin_amdgcn_s_setprio(0); } while (0)
#define PG8_WAIT_V(n) asm volatile("s_waitcnt vmcnt(" #n ")" ::: "memory")
#define PG8_WAIT_L(n) asm volatile("s_waitcnt lgkmcnt(" #n ")" ::: "memory")
#define PG8_BAR __builtin_amdgcn_s_barrier()
#define PG8_SCHED __builtin_amdgcn_sched_barrier(0)
    Unit cur, nxt; int ui = 0;
    if (!S.next(0, cur)) return;
    f32x4 acc[2][2][4][2];
#pragma unroll
    for (int a = 0; a < 2; ++a)
#pragma unroll
        for (int b = 0; b < 2; ++b)
#pragma unroll
            for (int m = 0; m < 4; ++m)
#pragma unroll
                for (int n = 0; n < 2; ++n) acc[a][b][m][n] = (f32x4){0.f, 0.f, 0.f, 0.f};
    bf16x8 At[4][2], B0[2][2], B1[2][2];
    const char* cA = (const char*)g.A + (size_t)cur.pm * tstepA + (size_t)cur.ko * 2; const char* cB = (const char*)g.Bt + (size_t)cur.pn * tstepB + (size_t)cur.ko * 2;
    PG8_STAGE(PG8_SB(0, 0), cB, voffB); PG8_STAGE(PG8_SB(0, 1), cB + hstepB, voffB); PG8_STAGE(PG8_SA(0, 0), cA, voffA); PG8_STAGE(PG8_SA(0, 1), cA + hstepA, voffA);
    if (wr == 1) PG8_BAR;
    PG8_WAIT_V(2); PG8_BAR;
    PG8_STAGE(PG8_SB(1, 0), cB + kstep, voffB); PG8_STAGE(PG8_SA(1, 0), cA + kstep, voffA); PG8_STAGE(PG8_SB(1, 1), cB + hstepB + kstep, voffB);
    PG8_WAIT_V(6); PG8_BAR;
    for (;;) {
        const bool has_next = S.next(ui + 1, nxt);
        const char* nA = has_next ? (const char*)g.A + (size_t)nxt.pm * tstepA + (size_t)nxt.ko * 2 : cA; const char* nB = has_next ? (const char*)g.Bt + (size_t)nxt.pn * tstepB + (size_t)nxt.ko * 2 : cB;
        for (int t = 0; t < nt; t += 2) {
            const bool last = (t == nt - 2);
            const char* a1 = cA + (size_t)(t + 1) * kstep;
            const char* a2 = last ? nA : cA + (size_t)(t + 2) * kstep; const char* b2 = last ? nB : cB + (size_t)(t + 2) * kstep;
            const char* a3 = a2 + kstep; const char* b3 = b2 + kstep;
            PG8_LDB(B0, 0, 0); PG8_LDB(B1, 0, 1); PG8_SCHED; PG8_LDA(At, 0, 0); PG8_STAGE(PG8_SA(1, 1), a1 + hstepA, voffA);
            PG8_WAIT_V(8); PG8_WAIT_L(0); PG8_BAR; PG8_MMA(0, 0, At, B0); PG8_MMA(0, 1, At, B1); PG8_BAR; PG8_SCHED;
            PG8_LDA(At, 0, 1); PG8_STAGE(PG8_SB(0, 0), b2, voffB); PG8_STAGE(PG8_SB(0, 1), b2 + hstepB, voffB); PG8_STAGE(PG8_SA(0, 0), a2, voffA);
            PG8_WAIT_V(8); PG8_WAIT_L(0); PG8_BAR; PG8_MMA(1, 0, At, B0); PG8_MMA(1, 1, At, B1); PG8_BAR; PG8_SCHED;
            PG8_LDB(B0, 1, 0); PG8_LDB(B1, 1, 1); PG8_SCHED; PG8_LDA(At, 1, 0); PG8_STAGE(PG8_SA(0, 1), a2 + hstepA, voffA);
            PG8_WAIT_V(8); PG8_WAIT_L(0); PG8_BAR; PG8_MMA(0, 0, At, B0); PG8_MMA(0, 1, At, B1); PG8_BAR; PG8_SCHED;
            PG8_LDA(At, 1, 1); PG8_STAGE(PG8_SB(1, 0), b3, voffB); PG8_STAGE(PG8_SB(1, 1), b3 + hstepB, voffB); PG8_STAGE(PG8_SA(1, 0), a3, voffA);
            PG8_WAIT_V(8); PG8_WAIT_L(0); PG8_BAR; PG8_MMA(1, 0, At, B0); PG8_MMA(1, 1, At, B1); PG8_BAR; PG8_SCHED;
        }
        if (wr == 0) PG8_BAR;
        E(acc, cur, wr, wc, fr, fq);
        if (!has_next) break;
#pragma unroll
        for (int a = 0; a < 2; ++a)
#pragma unroll
            for (int b = 0; b < 2; ++b)
#pragma unroll
                for (int m = 0; m < 4; ++m)
#pragma unroll
                    for (int n = 0; n < 2; ++n) acc[a][b][m][n] = (f32x4){0.f, 0.f, 0.f, 0.f};
        cur = nxt; cA = nA; cB = nB; ++ui;
        if (wr == 1) PG8_BAR;
    }
    PG8_WAIT_V(0);
    PG8_BAR;
#undef PG8_SA
#undef PG8_SB
#undef PG8_STAGE
#undef PG8_LDA
#undef PG8_LDB
#undef PG8_MMA
#undef PG8_WAIT_V
#undef PG8_WAIT_L
#undef PG8_BAR
#undef PG8_SCHED
}
}
using pg8::Unit;

#define EPI_ROWS(ri, row) _Pragma("unroll") for (int ai = 0; ai < 2; ++ai) _Pragma("unroll") for (int m = 0; m < 4; ++m) { const int ri = ai * 4 + m; const int row = u.pm * 256 + ai * 128 + wr * 64 + m * 16 + fr;
#define EPI_COLS(col, v) _Pragma("unroll") for (int bj = 0; bj < 2; ++bj) _Pragma("unroll") for (int n = 0; n < 2; ++n) { const int col = u.pn * 256 + bj * 128 + wc * 32 + n * 16 + fq * 4; f32x4& v = acc[ai][bj][m][n];
#define EPI_END }
typedef f32x4 Acc[2][2][4][2];

DI float dot4(f32x4 v) { return (v[0] * v[0] + v[1] * v[1]) + (v[2] * v[2] + v[3] * v[3]); }

struct EpiIn {
    static constexpr bool HAS_MID = false; int tmid;
    bf16_t *CQ, *CKV, *QN, *KVC, *KVS, *KVW; float *KR, *GATE, *SSQQ, *SSQKV;
    DI void mid(Acc&, const Unit&, int, int, int, int) const {}
    DI void operator()(Acc& acc, const Unit& u, int wr, int wc, int fr, int fq) const {
        EPI_ROWS(ri, row)
            EPI_COLS(col, v)
                if (col < 512) { *(u32x2*)(CQ + (size_t)row * 512 + col) = pk4(v); }
                else if (col < 768) { *(u32x2*)(CKV + (size_t)row * 256 + (col - 512)) = pk4(v); }
                else if (col < 832) { *(f32x4*)(KR + (size_t)row * 64 + (col - 768)) = v; }
                else if (col < 1856) { *(u32x2*)(QN + (size_t)row * 1024 + (col - 832)) = pk4(v * QS_NSA); }
                else if (col < 2624) { const int cc = col - 1856, kind = cc >> 8, c2 = cc & 255, g = c2 >> 7, d = c2 & 127, isv = d >> 6;
                    *(u32x2*)(KVC + (size_t)kind * (4 * MiB / 2) + ((size_t)(isv * 2 + g) * T + row) * 64 + (d & 63)) = pk4(v); }
                else if (col < 2672) { f32x4 s;
#pragma unroll
                    for (int j = 0; j < 4; ++j) s[j] = 1.f / (1.f + __expf(-v[j]));
                    *(f32x4*)(GATE + (size_t)row * 48 + (col - 2624)) = s; }
            EPI_END
        EPI_END
        if (u.pn <= 2) {
            EPI_ROWS(ri, row)
                float s = (dot4(acc[ai][0][m][0]) + dot4(acc[ai][0][m][1])) + (dot4(acc[ai][1][m][0]) + dot4(acc[ai][1][m][1]));
                s += __shfl_xor(s, 16); s += __shfl_xor(s, 32);
                if (fq == 0) { if (u.pn < 2) SSQQ[(size_t)row * 8 + u.pn * 4 + wc] = s; else SSQKV[(size_t)row * 4 + wc] = s; }
            EPI_END
        }
    }
};
struct EpiQ {
    static constexpr bool HAS_MID = false; int tmid;
    bf16_t* QM; const float *SSQQ, *COS, *SIN;
    DI void mid(Acc&, const Unit&, int, int, int, int) const {}
    DI void operator()(Acc& acc, const Unit& u, int wr, int wc, int fr, int fq) const {
        EPI_ROWS(ri, row)
            const f32x4 a = *(const f32x4*)(SSQQ + (size_t)row * 8), b = *(const f32x4*)(SSQQ + (size_t)row * 8 + 4);
            const float r = rsqrtf(((a[0] + a[1]) + (a[2] + a[3]) + (b[0] + b[1]) + (b[2] + b[3])) * (1.f / 512.f) + EPS);
            EPI_COLS(col, v)
                const int h = col / 192, p = col - h * 192;
                f32x4 x = v * r;
                if (p >= 128) { const int i = (p - 128) >> 1;
                    const f32x2 c = *(const f32x2*)(COS + (size_t)row * 32 + i), s = *(const f32x2*)(SIN + (size_t)row * 32 + i);
                    f32x4 o; o[0] = x[0] * c[0] - x[1] * s[0]; o[1] = x[1] * c[0] + x[0] * s[0]; o[2] = x[2] * c[1] - x[3] * s[1]; o[3] = x[3] * c[1] + x[2] * s[1]; x = o; }
                *(u32x2*)(QM + (size_t)row * 1536 + col) = pk4(x * QS_MLA);
            EPI_END
        EPI_END
    }
};
struct EpiKV {
    static constexpr bool HAS_MID = false; int tmid;
    bf16_t *KM, *VM; const float* SSQKV;
    DI void mid(Acc&, const Unit&, int, int, int, int) const {}
    DI void operator()(Acc& acc, const Unit& u, int wr, int wc, int fr, int fq) const {
        EPI_ROWS(ri, row)
            const f32x4 a = *(const f32x4*)(SSQKV + (size_t)row * 4);
            const float r = rsqrtf(((a[0] + a[1]) + (a[2] + a[3])) * (1.f / 256.f) + EPS);
            EPI_COLS(col, v)
                const int h = col >> 8, d = col & 255;
                const u32x2 w = pk4(v * r);
                if (d < 128) *(u32x2*)(KM + (size_t)row * 1536 + h * 192 + d) = w;
                else *(u32x2*)(VM + (size_t)row * 1024 + h * 128 + (d - 128)) = w;
            EPI_END
        EPI_END
    }
};
DI float gelu_tanh(float x) { const float z = 0.7978845608028654f * (x + 0.044715f * x * x * x); const float e = __expf(2.f * z); const float th = 1.f - 2.f / (e + 1.f); return 0.5f * x * (1.f + th); }
struct EpiHid {
    static constexpr bool HAS_MID = false; int tmid;
    bf16_t* HID; const float* B1;
    DI void mid(Acc&, const Unit&, int, int, int, int) const {}
    DI void operator()(Acc& acc, const Unit& u, int wr, int wc, int fr, int fq) const {
        EPI_ROWS(ri, row)
            EPI_COLS(col, v)
                const f32x4 b = *(const f32x4*)(B1 + col); f32x4 o;
#pragma unroll
                for (int j = 0; j < 4; ++j) o[j] = gelu_tanh(v[j] + b[j]);
                *(u32x2*)(HID + (size_t)row * 256 + col) = pk4(o);
            EPI_END
        EPI_END
    }
};
struct EpiO {
    static constexpr bool HAS_MID = false; int tmid;
    const float *X, *SSQM, *SSQN; float *H, *SSQ2; bf16_t* HB;
    DI void mid(Acc&, const Unit&, int, int, int, int) const {}
    DI void operator()(Acc& acc, const Unit& u, int wr, int wc, int fr, int fq) const {
        if (u.ko == 0) {
            EPI_ROWS(ri, row)
                const f32x4 a = *(const f32x4*)(SSQM + (size_t)row * 8), b = *(const f32x4*)(SSQM + (size_t)row * 8 + 4);
                const float rm = rsqrtf(((a[0] + a[1]) + (a[2] + a[3]) + (b[0] + b[1]) + (b[2] + b[3])) * (1.f / 1024.f) + EPS);
                EPI_COLS(col, v)
                    const f32x4 x = *(const f32x4*)(X + (size_t)row * DM + col);
                    *(f32x4*)(H + (size_t)row * DM + col) = x + v * rm;
                EPI_END
                asm volatile("" ::: "memory");
            EPI_END
        } else {
            EPI_ROWS(ri, row)
                const f32x2 c = *(const f32x2*)(SSQN + (size_t)row * 2);
                const float rn = rsqrtf((c[0] + c[1]) * (1.f / 1024.f) + EPS); float ss = 0.f;
                EPI_COLS(col, v)
                    const f32x4 h = *(const f32x4*)(H + (size_t)row * DM + col) + v * rn;
                    *(f32x4*)(H + (size_t)row * DM + col) = h; *(u32x2*)(HB + (size_t)row * DM + col) = pk4(h); ss += dot4(h);
                EPI_END
                ss += __shfl_xor(ss, 16); ss += __shfl_xor(ss, 32);
                if (fq == 0) SSQ2[(size_t)row * 32 + u.pn * 4 + wc] = ss;
                asm volatile("" ::: "memory");
            EPI_END
        }
    }
};
DI float sum32(const float* p) { float s = 0.f;
#pragma unroll
    for (int j = 0; j < 8; ++j) { const f32x4 a = *(const f32x4*)(p + 4 * j); s += (a[0] + a[1]) + (a[2] + a[3]); }
    return s; }
struct EpiUp {
    static constexpr bool HAS_MID = false; int tmid;
    const float* SSQ2; bf16_t* U;
    DI void mid(Acc&, const Unit&, int, int, int, int) const {}
    DI void operator()(Acc& acc, const Unit& u, int wr, int wc, int fr, int fq) const {
        EPI_ROWS(ri, row)
            const float r = rsqrtf(sum32(SSQ2 + (size_t)row * 32) * (1.f / 2048.f) + EPS);
            EPI_COLS(col, v)
                f32x4 o;
#pragma unroll
                for (int j = 0; j < 4; ++j) { const float a = fmaxf(v[j] * r, 0.f); o[j] = a * a; }
                *(u32x2*)(U + (size_t)row * MLPH + col) = pk4(o);
            EPI_END
        EPI_END
    }
};
struct EpiDown {
    static constexpr bool HAS_MID = false; int tmid;
    float *H, *SSQ3;
    DI void mid(Acc&, const Unit&, int, int, int, int) const {}
    DI void operator()(Acc& acc, const Unit& u, int wr, int wc, int fr, int fq) const {
        EPI_ROWS(ri, row)
            float ss = 0.f;
            EPI_COLS(col, v)
                const f32x4 o = *(const f32x4*)(H + (size_t)row * DM + col) + v;
                *(f32x4*)(H + (size_t)row * DM + col) = o; ss += dot4(o);
            EPI_END
            ss += __shfl_xor(ss, 16); ss += __shfl_xor(ss, 32);
            if (fq == 0) SSQ3[(size_t)row * 32 + u.pn * 4 + wc] = ss;
        EPI_END
    }
};

struct Params {
    const float *x, *attn_norm_w, *w_in, *mla_q_norm_w, *mla_w_uq, *mla_kv_norm_w, *mla_w_ukv, *cmp_pos_k, *cmp_pos_v, *cmp_w1_k, *cmp_w2_k,
        *cmp_w1_v, *cmp_w2_v, *mla_out_norm_w, *nsa_out_norm_w, *w_o, *mlp_norm_w, *w_up, *w_down, *final_norm_w;
    const int* positions;
    float* out; unsigned char* ws;
};

template <class RowMap>
DI void transpose_item(const float* W, int K, int N, bf16_t* WT, const float* kscale, const float* kscale2, int ksplit, LAS float* scr, int item, int lane, RowMap rowmap) {
    const int nblk = (N + 31) / 32, kb = item / nblk, nb = item % nblk, k0 = 64 * kb, n0 = 32 * nb;
    const int nn = n0 + (lane & 31);
#pragma unroll 8
    for (int i = 0; i < 32; ++i) { const int kk = 2 * i + (lane >> 5); const int k = k0 + kk;
        float v = nn < N ? W[(size_t)k * N + nn] : 0.f;
        if (kscale) v *= (k < ksplit ? kscale[k] : kscale2[k - ksplit]);
        scr[kk * 33 + (lane & 31)] = v; }
    asm volatile("s_waitcnt lgkmcnt(0)" ::: "memory");
    const int c = lane & 7;
#pragma unroll
    for (int j = 0; j < 4; ++j) { const int n = (lane >> 3) + 8 * j; const LAS float* s = scr + (8 * c) * 33 + n;
        u32x4 o; o.x = pk2(s[0 * 33], s[1 * 33]); o.y = pk2(s[2 * 33], s[3 * 33]); o.z = pk2(s[4 * 33], s[5 * 33]); o.w = pk2(s[6 * 33], s[7 * 33]);
        if (n0 + n < N) *(u32x4*)(WT + (size_t)rowmap(n0 + n) * K + k0 + 8 * c) = o; }
    asm volatile("s_waitcnt lgkmcnt(0)" ::: "memory");
}
struct RowId { DI int operator()(int n) const { return n; } };
struct RowUq { DI int operator()(int n) const { const int h = n / 192, d = n - h * 192; if (d < 128) return n; const int i = d - 128; return h * 192 + 128 + (i < 32 ? 2 * i : 2 * (i - 32) + 1); } };

DI void sincos_acc(float a, float& sn, float& cs) {
    const double ad = (double)a;
    const double q = __builtin_rint(ad * 0.6366197723675814);
    const double r = (ad - q * 1.5707963267948966) - q * 6.123233995736766e-17;
    const double r2 = r * r;
    const double sp = r * (1.0 + r2 * (-1.0 / 6 + r2 * (1.0 / 120 + r2 * (-1.0 / 5040 + r2 * (1.0 / 362880 + r2 * (-1.0 / 39916800))))));
    const double cp = 1.0 + r2 * (-0.5 + r2 * (1.0 / 24 + r2 * (-1.0 / 720 + r2 * (1.0 / 40320 + r2 * (-1.0 / 3628800 + r2 * (1.0 / 479001600))))));
    const int qi = ((int)q) & 3;
    const double s = (qi == 0) ? sp : (qi == 1) ? cp : (qi == 2) ? -sp : -cp;
    const double c = (qi == 0) ? cp : (qi == 1) ? -sp : (qi == 2) ? -cp : sp;
    sn = (float)s; cs = (float)c;
}

DI void p0_prep(const Params& P, LAS unsigned char* lds, int G) {
    const int tid = threadIdx.x, lane = tid & 63, wave = __builtin_amdgcn_readfirstlane(tid >> 6);
    LAS float* scr = (LAS float*)(lds + wave * 16384);
    const int gw = blockIdx.x * 8 + wave, NGW = G * 8;
    unsigned char* ws = P.ws;
    bf16_t* Win_t = (bf16_t*)(ws + WS_WIN); bf16_t* Wuq_t = (bf16_t*)(ws + WS_WUQ); bf16_t* Wukv_t = (bf16_t*)(ws + WS_WUKV);
    bf16_t* W1k_t = (bf16_t*)(ws + WS_W1K); bf16_t* W1v_t = (bf16_t*)(ws + WS_W1V); bf16_t* Wo_t = (bf16_t*)(ws + WS_WO);
    bf16_t* Wup_t = (bf16_t*)(ws + WS_WUP); bf16_t* Wdn_t = (bf16_t*)(ws + WS_WDN);
    constexpr int I_IN = (DM / 64) * ((INW + 31) / 32), I_UQ = (QRANK / 64) * (1536 / 32), I_UKV = (KVRANK / 64) * (2048 / 32), I_W1 = (2048 / 64) * (256 / 32),
                  I_O = (DM / 64) * (DM / 32), I_UP = (DM / 64) * (MLPH / 32), I_DN = (MLPH / 64) * (DM / 32);
    constexpr int NITEMS = I_IN + I_UQ + I_UKV + 2 * I_W1 + I_O + I_UP + I_DN;
    for (int it = gw; it < NITEMS; it += NGW) {
        int r = it;
        if (r < I_UP) { transpose_item(P.w_up, DM, MLPH, Wup_t, P.mlp_norm_w, P.mlp_norm_w, DM, scr, r, lane, RowId()); continue; } r -= I_UP;
        if (r < I_DN) { transpose_item(P.w_down, MLPH, DM, Wdn_t, nullptr, nullptr, 0, scr, r, lane, RowId()); continue; } r -= I_DN;
        if (r < I_IN) { transpose_item(P.w_in, DM, INW, Win_t, nullptr, nullptr, 0, scr, r, lane, RowId()); continue; } r -= I_IN;
        if (r < I_O) { transpose_item(P.w_o, DM, DM, Wo_t, P.mla_out_norm_w, P.nsa_out_norm_w, 1024, scr, r, lane, RowId()); continue; } r -= I_O;
        if (r < I_UQ) { transpose_item(P.mla_w_uq, QRANK, 1536, Wuq_t, P.mla_q_norm_w, P.mla_q_norm_w, QRANK, scr, r, lane, RowUq()); continue; } r -= I_UQ;
        if (r < I_UKV) { transpose_item(P.mla_w_ukv, KVRANK, 2048, Wukv_t, P.mla_kv_norm_w, P.mla_kv_norm_w, KVRANK, scr, r, lane, RowId()); continue; } r -= I_UKV;
        if (r < I_W1) { transpose_item(P.cmp_w1_k, 2048, 256, W1k_t, nullptr, nullptr, 0, scr, r, lane, RowId()); continue; } r -= I_W1;
        transpose_item(P.cmp_w1_v, 2048, 256, W1v_t, nullptr, nullptr, 0, scr, r, lane, RowId());
    }
    bf16_t* XN = (bf16_t*)(ws + WS_XN);
    for (int row = gw; row < T; row += NGW) {
        const f32x4* xr = (const f32x4*)(P.x + (size_t)row * DM) + lane;
        f32x4 v[8]; float s = 0.f;
#pragma unroll
        for (int j = 0; j < 8; ++j) { v[j] = xr[64 * j]; s += dot4(v[j]); }
        const float r = rsqrtf(wave_sum(s) * (1.f / DM) + EPS);
#pragma unroll
        for (int j = 0; j < 8; ++j) { const f32x4 w = *((const f32x4*)P.attn_norm_w + lane + 64 * j);
            *(u32x2*)(XN + (size_t)row * DM + (lane + 64 * j) * 4) = pk4(v[j] * r * w); }
    }
    const int gt = blockIdx.x * 512 + tid, NGT = G * 512;
    for (int i = gt; i < (INWP - INW) * DM / 8; i += NGT) *(u32x4*)(Win_t + (size_t)INW * DM + (size_t)i * 8) = (u32x4){0u, 0u, 0u, 0u};
    float* COS = (float*)(ws + WS_COS); float* SIN = (float*)(ws + WS_SIN);
    for (int i = gt; i < T * 32; i += NGT) { const int t = i >> 5, j = i & 31;
        const float ex = (float)(2 * j) / 64.0f;
        const float pw = (float)exp((double)ex * 9.210340371976184);
        const float inv = 1.0f / pw;
        const float ang = (float)P.positions[t] * inv;
        float sn, cs; sincos_acc(ang, sn, cs); COS[i] = cs; SIN[i] = sn; }
    float* B1 = (float*)(ws + WS_B1);
    for (int i = gt; i < 512; i += NGT) { const int kv = i >> 8, n = i & 255; const float* pos = kv ? P.cmp_pos_v : P.cmp_pos_k; const float* w1 = kv ? P.cmp_w1_v : P.cmp_w1_k;
        float s = 0.f; for (int k = 0; k < 2048; ++k) s += pos[k] * w1[(size_t)k * 256 + n]; B1[i] = s; }
}

DI f32x16 mfma32(bf16x8 a, bf16x8 b, f32x16 c) { return __builtin_amdgcn_mfma_f32_32x32x16_bf16(a, b, c, 0, 0, 0); }
typedef short v4i16_t __attribute__((ext_vector_type(4)));
DI s16x4 vtr(const LAS char* p) { return __builtin_bit_cast(s16x4, __builtin_amdgcn_ds_read_tr16_b64_v4i16((LAS v4i16_t*)p)); }
DI int crow(int r, int hi) { return (r & 3) + 8 * (r >> 2) + 4 * hi; }
#define CR(r) (((r) & 3) + 8 * ((r) >> 2))

template <int NKS, int PKB>
DI void qk_tile(const LAS char* Kt, const bf16x8* qf, int r32, int hi, f32x16& s0, f32x16& s1) {
    const LAS char* kb = Kt + r32 * PKB + hi * 16;
#pragma unroll
    for (int ks = 0; ks < NKS; ++ks) {
        const bf16x8 a0 = *(const LAS bf16x8*)(kb + ks * 32);
        const bf16x8 a1 = *(const LAS bf16x8*)(kb + 32 * PKB + ks * 32);
        s0 = mfma32(a0, qf[ks], s0); s1 = mfma32(a1, qf[ks], s1);
    }
}
template <int ND0, int PVB>
DI void pv_tile(const LAS char* Vt, const f32x16& p0, const f32x16& p1, f32x16* o, int lane) {
    const int hi = lane >> 5, q = (lane & 15) >> 2, p = lane & 3, blk = (lane >> 4) & 1;
    const LAS char* vb = Vt + (4 * hi + q) * PVB + (16 * blk + 4 * p) * 2;
    bf16x8 pa[4];
    { u32x4 w;
      w.x = pk2(p0[0], p0[1]); w.y = pk2(p0[2], p0[3]); w.z = pk2(p0[4], p0[5]); w.w = pk2(p0[6], p0[7]); pa[0] = __builtin_bit_cast(bf16x8, w);
      w.x = pk2(p0[8], p0[9]); w.y = pk2(p0[10], p0[11]); w.z = pk2(p0[12], p0[13]); w.w = pk2(p0[14], p0[15]); pa[1] = __builtin_bit_cast(bf16x8, w);
      w.x = pk2(p1[0], p1[1]); w.y = pk2(p1[2], p1[3]); w.z = pk2(p1[4], p1[5]); w.w = pk2(p1[6], p1[7]); pa[2] = __builtin_bit_cast(bf16x8, w);
      w.x = pk2(p1[8], p1[9]); w.y = pk2(p1[10], p1[11]); w.z = pk2(p1[12], p1[13]); w.w = pk2(p1[14], p1[15]); pa[3] = __builtin_bit_cast(bf16x8, w); }
#pragma unroll
    for (int d0 = 0; d0 < ND0; ++d0) {
#pragma unroll
        for (int kk = 0; kk < 4; ++kk) {
            const s16x4 lo = vtr(vb + (16 * kk) * PVB + d0 * 64);
            const s16x4 hh = vtr(vb + (16 * kk + 8) * PVB + d0 * 64);
            const bf16x8 vf = (bf16x8){lo[0], lo[1], lo[2], lo[3], hh[0], hh[1], hh[2], hh[3]};
            o[d0] = mfma32(pa[kk], vf, o[d0]);
        }
        __builtin_amdgcn_sched_barrier(0);
    }
}
DI float rowmax32(const f32x16& s0, const f32x16& s1) {
    float a = fmaxf(s0[0], s1[0]);
#pragma unroll
    for (int r = 1; r < 16; ++r) a = fmaxf(a, fmaxf(s0[r], s1[r]));
    return fmaxf(a, __shfl_xor(a, 32));
}
template <int ND0>
DI void online_update(f32x16& s0, f32x16& s1, float& m, float& l, f32x16* o, LAS float* wsf, int r32, int hi) {
    const float mx = rowmax32(s0, s1);
    const float mnew = fmaxf(m, mx);
    const float alpha = __builtin_amdgcn_exp2f(m - mnew);
    if constexpr (ND0 > 0) {
        if (__any(mnew > m)) {
            if (hi == 0) wsf[r32] = alpha;
            asm volatile("s_waitcnt lgkmcnt(0)" ::: "memory");
#pragma unroll
            for (int r = 0; r < 16; ++r) { const float a = wsf[crow(r, hi)];
#pragma unroll
                for (int d = 0; d < ND0; ++d) o[d][r] *= a; }
            asm volatile("s_waitcnt lgkmcnt(0)" ::: "memory");
        }
    }
    m = mnew;
    float ls = 0.f;
#pragma unroll
    for (int r = 0; r < 16; ++r) { s0[r] = __builtin_amdgcn_exp2f(s0[r] - mnew); s1[r] = __builtin_amdgcn_exp2f(s1[r] - mnew); ls += s0[r] + s1[r]; }
    l = l * alpha + ls;
}

constexpr int MLA_PK = 400, MLA_PV = 320, MLA_KB = 64 * MLA_PK, MLA_VB = 64 * MLA_PV;
constexpr int MLA_WS = 2 * MLA_KB + 2 * MLA_VB;
DI void mla_unit(const Params& P, LAS unsigned char* lds, int h, int qb) {
    int tid_ = threadIdx.x; asm volatile("" : "+v"(tid_));
    const int tid = tid_, lane = tid & 63, wave = __builtin_amdgcn_readfirstlane(tid >> 6), r32 = lane & 31, hi = lane >> 5;
    const bf16_t* QM = (const bf16_t*)(P.ws + WS_QM); const bf16_t* KM = (const bf16_t*)(P.ws + WS_KM); const bf16_t* VM = (const bf16_t*)(P.ws + WS_VM);
    bf16_t* Y = (bf16_t*)(P.ws + WS_XN); float* SSQM = (float*)(P.ws + WS_SSQM);
    LAS float* wsf = (LAS float*)(lds + MLA_WS + wave * 256);
    const int q0 = qb * 256 + wave * 32;
    bf16x8 qf[12];
    { const bf16_t* qp = QM + (size_t)(q0 + r32) * 1536 + h * 192 + hi * 8;
#pragma unroll
      for (int ks = 0; ks < 12; ++ks) qf[ks] = *(const bf16x8*)(qp + ks * 16); }
    f32x16 o[4];
#pragma unroll
    for (int d = 0; d < 4; ++d)
#pragma unroll
        for (int r = 0; r < 16; ++r) o[d][r] = 0.f;
    float m = NEGBIG, l = 0.f;
    const int NT = 4 * qb + 4;
    int krow[3], kch[3], vrow[2], vch[2];
#pragma unroll
    for (int i = 0; i < 3; ++i) { const int idx = tid + 512 * i; krow[i] = idx / 24; kch[i] = idx - krow[i] * 24; }
#pragma unroll
    for (int i = 0; i < 2; ++i) { const int idx = tid + 512 * i; vrow[i] = idx >> 4; vch[i] = idx & 15; }
    u32x4 kreg[3], vreg[2];
#define MLA_LOAD(t) do { _Pragma("unroll") for (int i = 0; i < 3; ++i) kreg[i] = *(const u32x4*)(KM + (size_t)((t) * 64 + krow[i]) * 1536 + h * 192 + kch[i] * 8); \
                         _Pragma("unroll") for (int i = 0; i < 2; ++i) vreg[i] = *(const u32x4*)(VM + (size_t)((t) * 64 + vrow[i]) * 1024 + h * 128 + vch[i] * 8); } while (0)
#define MLA_WRITE(b) do { _Pragma("unroll") for (int i = 0; i < 3; ++i) *(LAS u32x4*)(lds + (b) * MLA_KB + krow[i] * MLA_PK + kch[i] * 16) = kreg[i]; \
                          _Pragma("unroll") for (int i = 0; i < 2; ++i) *(LAS u32x4*)(lds + 2 * MLA_KB + (b) * MLA_VB + vrow[i] * MLA_PV + vch[i] * 16) = vreg[i]; } while (0)
    MLA_LOAD(0); MLA_WRITE(0);
    __syncthreads();
    for (int t = 0; t < NT; ++t) {
        const int b = t & 1;
        if (t + 1 < NT) MLA_LOAD(t + 1);
        const int k0 = t * 64;
        if (k0 <= q0 + 31) {
            f32x16 s0, s1;
#pragma unroll
            for (int r = 0; r < 16; ++r) { s0[r] = 0.f; s1[r] = 0.f; }
            qk_tile<12, MLA_PK>((const LAS char*)(lds + b * MLA_KB), qf, r32, hi, s0, s1);
            if (k0 + 63 > q0) {
                const int d0 = q0 + r32 - k0 - 4 * hi;
#pragma unroll
                for (int r = 0; r < 16; ++r) { if (CR(r) > d0) s0[r] = NEGBIG; if (CR(r) + 32 > d0) s1[r] = NEGBIG; }
            }
            online_update<4>(s0, s1, m, l, o, wsf, r32, hi);
            pv_tile<4, MLA_PV>((const LAS char*)(lds + 2 * MLA_KB + b * MLA_VB), s0, s1, o, lane);
        }
        if (t + 1 < NT) MLA_WRITE(b ^ 1);
        __syncthreads();
    }
#undef MLA_LOAD
#undef MLA_WRITE
    const float lt = l + __shfl_xor(l, 32);
    if (hi == 0) wsf[r32] = 1.f / lt;
    asm volatile("s_waitcnt lgkmcnt(0)" ::: "memory");
#pragma unroll
    for (int r = 0; r < 16; ++r) {
        const int row = crow(r, hi); const float il = wsf[row]; float ss = 0.f;
#pragma unroll
        for (int d = 0; d < 4; ++d) { const float y = o[d][r] * il; ss += y * y;
            Y[(size_t)(q0 + row) * DM + h * 128 + d * 32 + r32] = (bf16_t)(pk2(y, 0.f) & 0xffffu); }
#pragma unroll
        for (int off = 1; off < 32; off <<= 1) ss += __shfl_xor(ss, off);
        if (r32 == 0) SSQM[(size_t)(q0 + row) * 8 + h] = ss;
    }
    __syncthreads();
}

constexpr int NSA_PK = 144, NSA_PV = 192, NSA_KB = 64 * NSA_PK, NSA_VB = 64 * NSA_PV;
constexpr int NSA_WS = NSA_KB + NSA_VB;
constexpr int NSA_WSZ = 4608;
constexpr int NSA_BU = NSA_WS + 8 * NSA_WSZ;

DI void nsa_stage(LAS unsigned char* lds, const bf16_t* Ks, const bf16_t* Vs, int tid) {
    const int row = tid >> 3, ch = tid & 7;
    const u32x4 kv = *(const u32x4*)(Ks + row * 64 + ch * 8), vv = *(const u32x4*)(Vs + row * 64 + ch * 8);
    *(LAS u32x4*)(lds + row * NSA_PK + ch * 16) = kv; *(LAS u32x4*)(lds + NSA_KB + row * NSA_PV + ch * 16) = vv;
}
DI void nsa_bias(f32x16& s0, f32x16& s1, float c0, float c1, float slc) {
    asm volatile("" : "+v"(slc));
#pragma unroll
    for (int r = 0; r < 16; ++r) { const float b = slc * (float)CR(r); s0[r] += c0 + b; s1[r] += c1 + b; }
}

DI void nsa_unit(const Params& P, LAS unsigned char* lds, int tile, int g) {
    int tid_ = threadIdx.x; asm volatile("" : "+v"(tid_));
    const int tid = tid_, lane = tid & 63, wave = __builtin_amdgcn_readfirstlane(tid >> 6), r32 = lane & 31, hi = lane >> 5;
    const unsigned char* ws = P.ws;
    const bf16_t* QN = (const bf16_t*)(ws + WS_QN);
    const bf16_t* KC = (const bf16_t*)(ws + WS_KC) + (size_t)g * 512 * 64; const bf16_t* VC = (const bf16_t*)(ws + WS_VC) + (size_t)g * 512 * 64;
    const bf16_t* KS = (const bf16_t*)(ws + WS_KVS) + (size_t)g * T * 64; const bf16_t* VS = (const bf16_t*)(ws + WS_KVS) + (size_t)(2 + g) * T * 64;
    const bf16_t* KW = (const bf16_t*)(ws + WS_KVW) + (size_t)g * T * 64; const bf16_t* VW = (const bf16_t*)(ws + WS_KVW) + (size_t)(2 + g) * T * 64;
    const float* GATE = (const float*)(ws + WS_GATE);
    bf16_t* Y = (bf16_t*)(P.ws + WS_XN); float* SSQN = (float*)(P.ws + WS_SSQN);
    LAS unsigned char* wsb = lds + NSA_WS + wave * NSA_WSZ;
    LAS float* wsf = (LAS float*)wsb; LAS unsigned* selm = (LAS unsigned*)(wsb + 128); LAS float* AE = (LAS float*)(wsb + 512);
    LAS unsigned* BU = (LAS unsigned*)(lds + NSA_BU);
    const LAS char* Kt = (const LAS char*)lds; const LAS char* Vt = (const LAS char*)(lds + NSA_KB);

    const int t0 = tile * 32, cur = t0 >> 6;
    const int tokl = r32 >> 3, head = r32 & 7, hidx = g * 8 + head;
    const int t = t0 + wave * 4 + tokl;
    const float sl2 = __builtin_amdgcn_exp2f(-0.5f * (float)(hidx + 1)) * LOG2E;
    bf16x8 qf[4];
    { const bf16_t* qp = QN + (size_t)t * 1024 + hidx * 64 + hi * 8;
#pragma unroll
      for (int ks = 0; ks < 4; ++ks) qf[ks] = *(const bf16x8*)(qp + ks * 16); }
    if (tid < 4) BU[tid] = 0u;
    f32x16 yacc[2];
#pragma unroll
    for (int d = 0; d < 2; ++d)
#pragma unroll
        for (int r = 0; r < 16; ++r) yacc[d][r] = 0.f;
    const float gc = GATE[(size_t)t * 48 + hidx * 3 + 0], gs = GATE[(size_t)t * 48 + hidx * 3 + 1], gw = GATE[(size_t)t * 48 + hidx * 3 + 2];

    const int ntc = ((t0 >> 4) + 1 + 63) >> 6;
    float mc = NEGBIG, lc = 0.f;
    for (int i = 0; i < ntc; ++i) {
        const int n0 = 64 * i;
        __syncthreads();
        nsa_stage(lds, KC + (size_t)n0 * 64, VC + (size_t)n0 * 64, tid);
        __syncthreads();
        f32x16 s0, s1;
#pragma unroll
        for (int r = 0; r < 16; ++r) { s0[r] = 0.f; s1[r] = 0.f; }
        qk_tile<4, NSA_PK>(Kt, qf, r32, hi, s0, s1);
        const int db = t - 31 - 16 * (n0 + 4 * hi);
        nsa_bias(s0, s1, -sl2 * (float)db, -sl2 * (float)(db - 512), sl2 * 16.f);
        if (16 * (n0 + 63) + 31 > t0) {
#pragma unroll
            for (int r = 0; r < 16; ++r) { if (16 * CR(r) > db) s0[r] = NEGBIG; if (16 * CR(r) + 512 > db) s1[r] = NEGBIG; }
        }
        online_update<0>(s0, s1, mc, lc, nullptr, wsf, r32, hi);
    }
    const float lct = lc + __shfl_xor(lc, 32);
    const float ilc = (t >= 31) ? 1.f / lct : 0.f;
    f32x16 oc[2];
#pragma unroll
    for (int d = 0; d < 2; ++d)
#pragma unroll
        for (int r = 0; r < 16; ++r) oc[d][r] = 0.f;
    for (int i = 0; i < ntc; ++i) {
        const int n0 = 64 * i;
        __syncthreads();
        nsa_stage(lds, KC + (size_t)n0 * 64, VC + (size_t)n0 * 64, tid);
        __syncthreads();
        f32x16 s0, s1;
#pragma unroll
        for (int r = 0; r < 16; ++r) { s0[r] = 0.f; s1[r] = 0.f; }
        qk_tile<4, NSA_PK>(Kt, qf, r32, hi, s0, s1);
        const int db = t - 31 - 16 * (n0 + 4 * hi);
        nsa_bias(s0, s1, -sl2 * (float)db, -sl2 * (float)(db - 512), sl2 * 16.f);
        if (16 * (n0 + 63) + 31 > t0) {
#pragma unroll
            for (int r = 0; r < 16; ++r) { if (16 * CR(r) > db) s0[r] = NEGBIG; if (16 * CR(r) + 512 > db) s1[r] = NEGBIG; }
        }
#pragma unroll
        for (int r = 0; r < 16; ++r) { s0[r] = __builtin_amdgcn_exp2f(s0[r] - mc) * ilc; s1[r] = __builtin_amdgcn_exp2f(s1[r] - mc) * ilc; }
#pragma unroll
        for (int kh = 0; kh < 2; ++kh)
#pragma unroll
            for (int qd = 0; qd < 4; ++qd) {
                const f32x16& s = kh ? s1 : s0;
                float a = (s[4 * qd] + s[4 * qd + 1]) + (s[4 * qd + 2] + s[4 * qd + 3]); float e = s[4 * qd + 3];
                a += __shfl_xor(a, 1); e += __shfl_xor(e, 1); a += __shfl_xor(a, 2); e += __shfl_xor(e, 2); a += __shfl_xor(a, 4); e += __shfl_xor(e, 4);
                if (head == 0) { const int blk = 16 * i + 8 * kh + 2 * qd + hi; AE[tokl * 128 + blk] = a; AE[512 + tokl * 128 + blk] = e; }
            }
        pv_tile<2, NSA_PV>(Vt, s0, s1, oc, lane);
    }
    if (hi == 0) wsf[r32] = gc;
    asm volatile("s_waitcnt lgkmcnt(0)" ::: "memory");
#pragma unroll
    for (int r = 0; r < 16; ++r) { const float a = wsf[crow(r, hi)]; yacc[0][r] += oc[0][r] * a; yacc[1][r] += oc[1][r] * a; }
    asm volatile("s_waitcnt lgkmcnt(0)" ::: "memory");

    unsigned wu0 = 0u, wu1 = 0u, wu2 = 0u, wu3 = 0u;
#pragma unroll 1
    for (int tk = 0; tk < 4; ++tk) {
        unsigned mk0 = 0u, mk1 = 0u, mk2 = 0u, mk3 = 0u;
        if (cur < 16) { mk0 = (cur == 31) ? 0xffffffffu : ((2u << cur) - 1u); }
        else {
            mk0 = 1u;
            { const int b = cur; if (b < 32) mk0 |= 1u << b; else if (b < 64) mk1 |= 1u << (b - 32); else if (b < 96) mk2 |= 1u << (b - 64); else mk3 |= 1u << (b - 96); }
            { const int b = cur - 1; if (b < 32) mk0 |= 1u << b; else if (b < 64) mk1 |= 1u << (b - 32); else if (b < 96) mk2 |= 1u << (b - 64); else mk3 |= 1u << (b - 96); }
            float v0 = -1.f, v1 = -1.f;
            { const int s = lane; if (s >= 1 && s <= cur - 2) v0 = AE[tk * 128 + s] + AE[512 + tk * 128 + s - 1]; }
            { const int s = lane + 64; if (s <= cur - 2) v1 = AE[tk * 128 + s] + AE[512 + tk * 128 + s - 1]; }
#pragma unroll 1
            for (int it = 0; it < 13; ++it) {
                float mv = fmaxf(v0, v1);
#pragma unroll
                for (int off = 32; off >= 1; off >>= 1) mv = fmaxf(mv, __shfl_xor(mv, off));
                const unsigned long long b0 = __ballot(v0 == mv), b1 = __ballot(v1 == mv);
                const int idx = b0 ? (__ffsll((long long)b0) - 1) : (64 + __ffsll((long long)b1) - 1);
                if (lane == (idx & 63)) { if (idx < 64) v0 = -1.f; else v1 = -1.f; }
                if (idx < 32) mk0 |= 1u << idx; else if (idx < 64) mk1 |= 1u << (idx - 32); else if (idx < 96) mk2 |= 1u << (idx - 64); else mk3 |= 1u << (idx - 96);
            }
        }
        mk0 = __builtin_amdgcn_readfirstlane(mk0); mk1 = __builtin_amdgcn_readfirstlane(mk1); mk2 = __builtin_amdgcn_readfirstlane(mk2); mk3 = __builtin_amdgcn_readfirstlane(mk3);
        if (lane == 0) { selm[tk * 4 + 0] = mk0; selm[tk * 4 + 1] = mk1; selm[tk * 4 + 2] = mk2; selm[tk * 4 + 3] = mk3; }
        wu0 |= mk0; wu1 |= mk1; wu2 |= mk2; wu3 |= mk3;
    }
    if (lane == 0) { atomicOr((unsigned*)&BU[0], wu0); atomicOr((unsigned*)&BU[1], wu1); atomicOr((unsigned*)&BU[2], wu2); atomicOr((unsigned*)&BU[3], wu3); }
    asm volatile("s_waitcnt lgkmcnt(0)" ::: "memory");
    const unsigned ms0 = selm[tokl * 4 + 0], ms1 = selm[tokl * 4 + 1], ms2 = selm[tokl * 4 + 2], ms3 = selm[tokl * 4 + 3];
    __syncthreads();
    unsigned bu[4]; bu[0] = __builtin_amdgcn_readfirstlane(BU[0]); bu[1] = __builtin_amdgcn_readfirstlane(BU[1]); bu[2] = __builtin_amdgcn_readfirstlane(BU[2]); bu[3] = __builtin_amdgcn_readfirstlane(BU[3]);

    {
        f32x16 o[2];
#pragma unroll
        for (int d = 0; d < 2; ++d)
#pragma unroll
            for (int r = 0; r < 16; ++r) o[d][r] = 0.f;
        float m = NEGBIG, l = 0.f;
        int b = cur;
        for (;;) {
            if (b < 32) bu[0] &= ~(1u << b); else if (b < 64) bu[1] &= ~(1u << (b - 32)); else if (b < 96) bu[2] &= ~(1u << (b - 64)); else bu[3] &= ~(1u << (b - 96));
            __syncthreads();
            nsa_stage(lds, KS + (size_t)b * 64 * 64, VS + (size_t)b * 64 * 64, tid);
            __syncthreads();
            const unsigned wuw = b < 32 ? wu0 : (b < 64 ? wu1 : (b < 96 ? wu2 : wu3));
            if ((wuw >> (b & 31)) & 1u) {
                const unsigned msw = b < 32 ? ms0 : (b < 64 ? ms1 : (b < 96 ? ms2 : ms3));
                const bool selme = (msw >> (b & 31)) & 1u;
                f32x16 s0, s1;
#pragma unroll
                for (int r = 0; r < 16; ++r) { s0[r] = 0.f; s1[r] = 0.f; }
                qk_tile<4, NSA_PK>(Kt, qf, r32, hi, s0, s1);
                const int db = t - 64 * b - 4 * hi;
                const float c0 = selme ? -sl2 * (float)db : NEGBIG, c1 = selme ? -sl2 * (float)(db - 32) : NEGBIG;
                nsa_bias(s0, s1, c0, c1, sl2);
                if (b == cur) {
#pragma unroll
                    for (int r = 0; r < 16; ++r) { if (CR(r) > db) s0[r] = NEGBIG; if (CR(r) + 32 > db) s1[r] = NEGBIG; }
                }
                online_update<2>(s0, s1, m, l, o, wsf, r32, hi);
                pv_tile<2, NSA_PV>(Vt, s0, s1, o, lane);
            }
            if (bu[3]) b = 127 - __builtin_clz(bu[3]); else if (bu[2]) b = 95 - __builtin_clz(bu[2]); else if (bu[1]) b = 63 - __builtin_clz(bu[1]); else if (bu[0]) b = 31 - __builtin_clz(bu[0]); else break;
        }
        const float lt = l + __shfl_xor(l, 32);
        if (hi == 0) wsf[r32] = gs / lt;
        asm volatile("s_waitcnt lgkmcnt(0)" ::: "memory");
#pragma unroll
        for (int r = 0; r < 16; ++r) { const float a = wsf[crow(r, hi)]; yacc[0][r] += o[0][r] * a; yacc[1][r] += o[1][r] * a; }
        asm volatile("s_waitcnt lgkmcnt(0)" ::: "memory");
    }
    {
        f32x16 o[2];
#pragma unroll
        for (int d = 0; d < 2; ++d)
#pragma unroll
            for (int r = 0; r < 16; ++r) o[d][r] = 0.f;
        float m = NEGBIG, l = 0.f;
        const int ktlo = (t0 - 511) > 0 ? ((t0 - 511) >> 6) : 0;
        for (int kt = cur; kt >= ktlo; --kt) {
            __syncthreads();
            nsa_stage(lds, KW + (size_t)kt * 64 * 64, VW + (size_t)kt * 64 * 64, tid);
            __syncthreads();
            f32x16 s0, s1;
#pragma unroll
            for (int r = 0; r < 16; ++r) { s0[r] = 0.f; s1[r] = 0.f; }
            qk_tile<4, NSA_PK>(Kt, qf, r32, hi, s0, s1);
            const int db = t - 64 * kt - 4 * hi;
            nsa_bias(s0, s1, -sl2 * (float)db, -sl2 * (float)(db - 32), sl2);
            if (kt == cur) {
#pragma unroll
                for (int r = 0; r < 16; ++r) { if (CR(r) > db) s0[r] = NEGBIG; if (CR(r) + 32 > db) s1[r] = NEGBIG; }
            }
            if (t0 + 31 - 64 * kt >= 512) {
#pragma unroll
                for (int r = 0; r < 16; ++r) { if (db - CR(r) >= 512) s0[r] = NEGBIG; if (db - 32 - CR(r) >= 512) s1[r] = NEGBIG; }
            }
            online_update<2>(s0, s1, m, l, o, wsf, r32, hi);
            pv_tile<2, NSA_PV>(Vt, s0, s1, o, lane);
        }
        const float lt = l + __shfl_xor(l, 32);
        if (hi == 0) wsf[r32] = gw / lt;
        asm volatile("s_waitcnt lgkmcnt(0)" ::: "memory");
#pragma unroll
        for (int r = 0; r < 16; ++r) { const float a = wsf[crow(r, hi)]; yacc[0][r] += o[0][r] * a; yacc[1][r] += o[1][r] * a; }
        asm volatile("s_waitcnt lgkmcnt(0)" ::: "memory");
    }
    float ssq[4];
#pragma unroll
    for (int tk = 0; tk < 4; ++tk) ssq[tk] = 0.f;
#pragma unroll
    for (int r = 0; r < 16; ++r) {
        const int tk = r >> 2, hd = (r & 3) + 4 * hi;
#pragma unroll
        for (int d = 0; d < 2; ++d) { const float y = yacc[d][r]; ssq[tk] += y * y;
            Y[(size_t)(t0 + wave * 4 + tk) * DM + 1024 + (g * 8 + hd) * 64 + d * 32 + r32] = (bf16_t)(pk2(y, 0.f) & 0xffffu); }
    }
#pragma unroll
    for (int tk = 0; tk < 4; ++tk) { const float s = wave_sum(ssq[tk]); if (lane == 0) SSQN[(size_t)(t0 + wave * 4 + tk) * 2 + g] = s; }
    __syncthreads();
}

__global__ void __launch_bounds__(512, 2) mega_fwd(Params P) {
    extern __shared__ __attribute__((aligned(16))) unsigned char lds_raw[];
    LAS unsigned char* lds = (LAS unsigned char*)lds_raw;
    cg::grid_group grid = cg::this_grid();
    const int G = gridDim.x, tid = threadIdx.x, lane = tid & 63, wave = __builtin_amdgcn_readfirstlane(tid >> 6);
    unsigned char* ws = P.ws;
    p0_prep(P, lds, G);
    grid.sync();
    {
        pg8::Gemm g{(const bf16_t*)(ws + WS_XN), (const bf16_t*)(ws + WS_WIN), DM, DM, DM};
        pg8::Order S; S.init(T / 256, INWP / 256, G, blockIdx.x);
        EpiIn E{0, (bf16_t*)(ws + WS_CQ), (bf16_t*)(ws + WS_CKV), (bf16_t*)(ws + WS_QN), (bf16_t*)(ws + WS_KVC), (bf16_t*)(ws + WS_KVS), (bf16_t*)(ws + WS_KVW),
                (float*)(ws + WS_KR), (float*)(ws + WS_GATE), (float*)(ws + WS_SSQQ), (float*)(ws + WS_SSQKV)};
        pg8::gemm_phase(lds, g, S, E);
    }
    grid.sync();
    {
        { pg8::Gemm g{(const bf16_t*)(ws + WS_CKV), (const bf16_t*)(ws + WS_WUKV), KVRANK, KVRANK, KVRANK};
          pg8::Order S; S.init(T / 256, 2048 / 256, G, blockIdx.x);
          EpiKV E{0, (bf16_t*)(ws + WS_KM), (bf16_t*)(ws + WS_VM), (const float*)(ws + WS_SSQKV)};
          pg8::gemm_phase(lds, g, S, E); }
        { pg8::Gemm g{(const bf16_t*)(ws + WS_CQ), (const bf16_t*)(ws + WS_WUQ), QRANK, QRANK, QRANK};
          pg8::Order S; S.init(T / 256, 1536 / 256, G, (blockIdx.x + 64) % G);
          EpiQ E{0, (bf16_t*)(ws + WS_QM), (const float*)(ws + WS_SSQQ), (const float*)(ws + WS_COS), (const float*)(ws + WS_SIN)};
          pg8::gemm_phase(lds, g, S, E); }
        { pg8::Gemm g{(const bf16_t*)(ws + WS_KVC), (const bf16_t*)(ws + WS_W1K), 1024, 2048, 2048};
          pg8::Order S; S.init(4, 1, G, (blockIdx.x + 8) % G);
          EpiHid E{0, (bf16_t*)(ws + WS_HIDK), (const float*)(ws + WS_B1)};
          pg8::gemm_phase(lds, g, S, E); }
        { pg8::Gemm g{(const bf16_t*)(ws + WS_KVC) + (size_t)2 * T * 64, (const bf16_t*)(ws + WS_W1V), 1024, 2048, 2048};
          pg8::Order S; S.init(4, 1, G, (blockIdx.x + 4) % G);
          EpiHid E{0, (bf16_t*)(ws + WS_HIDV), (const float*)(ws + WS_B1) + 256};
          pg8::gemm_phase(lds, g, S, E); }
        const float* KR = (const float*)(ws + WS_KR); const float* COS = (const float*)(ws + WS_COS); const float* SIN = (const float*)(ws + WS_SIN);
        bf16_t* KM = (bf16_t*)(ws + WS_KM);
        for (int i = blockIdx.x * 512 + tid; i < T * 32; i += G * 512) { const int t = i >> 5, j = i & 31;
            const float x1 = KR[(size_t)t * 64 + j], x2 = KR[(size_t)t * 64 + 32 + j], c = COS[i], s = SIN[i];
            const unsigned w = pk2(x1 * c - x2 * s, x2 * c + x1 * s);
#pragma unroll
            for (int h = 0; h < 8; ++h) *(unsigned*)(KM + (size_t)t * 1536 + h * 192 + 128 + 2 * j) = w; }
    }
    grid.sync();
    {
        for (int i = blockIdx.x * 512 + tid; i < 2 * 1024 * 64; i += G * 512) { const int kv = i >> 16, row = (i >> 6) & 1023, col = i & 63;
            const bf16_t* hid = (const bf16_t*)(ws + (kv ? WS_HIDV : WS_HIDK)) + (size_t)row * 256; const float* w2 = kv ? P.cmp_w2_v : P.cmp_w2_k;
            float s = 0.f;
            if ((row & 511) != 511) { for (int k = 0; k < 256; ++k) s += bf2f(hid[k]) * w2[k * 64 + col]; }
            ((bf16_t*)(ws + (kv ? WS_VC : WS_KC)))[(size_t)row * 64 + col] = (bf16_t)(pk2(s, 0.f) & 0xffffu); }
    }
    grid.sync();
    {
        unsigned* ctr = (unsigned*)(ws + WS_CTL);
        LAS int* ubox = (LAS int*)(lds + LDS_BYTES - 16);
        for (;;) {
            if (tid == 0) *ubox = (int)atomicAdd(ctr, 1u);
            __syncthreads();
            const int u = __builtin_amdgcn_readfirstlane(*ubox);
            __syncthreads();
            if (u >= 256) break;
            mla_unit(P, lds, u & 7, 31 - (u >> 3));
        }
        for (;;) {
            if (tid == 0) *ubox = (int)atomicAdd(ctr + 64, 1u);
            __syncthreads();
            const int v = __builtin_amdgcn_readfirstlane(*ubox);
            __syncthreads();
            if (v >= 512) break;
            nsa_unit(P, lds, 255 - (v >> 1), v & 1);
        }
    }
    grid.sync();
    {
        pg8::Gemm g{(const bf16_t*)(ws + WS_XN), (const bf16_t*)(ws + WS_WO), DM, DM, 1024};
        pg8::Order2 S; S.init(T / 256, DM / 256, G, blockIdx.x, 1024);
        EpiO E{0, P.x, (const float*)(ws + WS_SSQM), (const float*)(ws + WS_SSQN), P.out, (float*)(ws + WS_SSQ2), (bf16_t*)(ws + WS_HB)};
        pg8::gemm_phase(lds, g, S, E);
    }
    grid.sync();
    {
        pg8::Gemm g{(const bf16_t*)(ws + WS_HB), (const bf16_t*)(ws + WS_WUP), DM, DM, DM};
        pg8::Order S; S.init(T / 256, MLPH / 256, G, blockIdx.x);
        EpiUp E{0, (const float*)(ws + WS_SSQ2), (bf16_t*)(ws + WS_U)};
        pg8::gemm_phase(lds, g, S, E);
    }
    grid.sync();
    {
        pg8::Gemm g{(const bf16_t*)(ws + WS_U), (const bf16_t*)(ws + WS_WDN), MLPH, MLPH, MLPH};
        pg8::Order S; S.init(T / 256, DM / 256, G, blockIdx.x);
        EpiDown E{0, P.out, (float*)(ws + WS_SSQ3)};
        pg8::gemm_phase(lds, g, S, E);
    }
    grid.sync();
    {
        const float* SSQ3 = (const float*)(ws + WS_SSQ3);
        for (int row = blockIdx.x * 8 + wave; row < T; row += G * 8) {
            const float r = rsqrtf(sum32(SSQ3 + (size_t)row * 32) * (1.f / DM) + EPS);
            f32x4* o = (f32x4*)(P.out + (size_t)row * DM) + lane;
#pragma unroll
            for (int j = 0; j < 8; ++j) { const f32x4 w = *((const f32x4*)P.final_norm_w + lane + 64 * j); o[64 * j] = o[64 * j] * r * w; }
        }
    }
}

extern "C" void kernel_launch(void* const* d_in, const int* in_sizes, int n_in, void* d_out, int out_size, void* d_ws, size_t ws_size, hipStream_t stream) {
    static int grid = 0;
    if (grid == 0) {
        if (n_in != 21 || out_size != T * DM || ws_size < WS_END) { fprintf(stderr, "kernel_launch: unexpected shapes (n_in %d out %d ws %zu)\n", n_in, out_size, ws_size); grid = -1; return; }
        int dev = 0, cus = 0, per_cu = 0;
        hipGetDevice(&dev);
        hipDeviceGetAttribute(&cus, hipDeviceAttributeMultiprocessorCount, dev);
        hipFuncSetAttribute((const void*)mega_fwd, hipFuncAttributeMaxDynamicSharedMemorySize, LDS_BYTES);
        hipOccupancyMaxActiveBlocksPerMultiprocessor(&per_cu, (const void*)mega_fwd, 512, LDS_BYTES);
        if (per_cu < 1) { fprintf(stderr, "kernel_launch: occupancy query reports %d blocks per CU\n", per_cu); per_cu = 1; }
        (void)hipGetLastError();
        grid = cus;
    }
    if (grid < 0) return;
    hipMemsetAsync((char*)d_ws + WS_CTL, 0, 4096, stream);
    Params p{};
    p.x = (const float*)d_in[0]; p.positions = (const int*)d_in[1]; p.attn_norm_w = (const float*)d_in[2]; p.w_in = (const float*)d_in[3];
    p.mla_q_norm_w = (const float*)d_in[4]; p.mla_w_uq = (const float*)d_in[5]; p.mla_kv_norm_w = (const float*)d_in[6]; p.mla_w_ukv = (const float*)d_in[7];
    p.cmp_pos_k = (const float*)d_in[8]; p.cmp_pos_v = (const float*)d_in[9]; p.cmp_w1_k = (const float*)d_in[10]; p.cmp_w2_k = (const float*)d_in[11];
    p.cmp_w1_v = (const float*)d_in[12]; p.cmp_w2_v = (const float*)d_in[13]; p.mla_out_norm_w = (const float*)d_in[14]; p.nsa_out_norm_w = (const float*)d_in[15];
    p.w_o = (const float*)d_in[16]; p.mlp_norm_w = (const float*)d_in[17]; p.w_up = (const float*)d_in[18]; p.w_down = (const float*)d_in[19]; p.final_norm_w = (const float*)d_in[20];
    p.out = (float*)d_out; p.ws = (unsigned char*)d_ws;
    void* args[] = {&p};
    hipError_t e = hipLaunchCooperativeKernel((const void*)mega_fwd, dim3(grid), dim3(512), args, LDS_BYTES, stream);
    if (e != hipSuccess) fprintf(stderr, "cooperative launch failed: %s (grid %d)\n", hipGetErrorString(e), grid);
}
```

```cpp
#include <hip/hip_runtime.h>
#include <hip/hip_cooperative_groups.h>
#include <cstdio>
#include <cstdint>
namespace cg = cooperative_groups;

#define DI __device__ __forceinline__
#define LAS __attribute__((address_space(3)))
typedef unsigned short bf16_t;
typedef short bf16x8 __attribute__((ext_vector_type(8)));
typedef short s16x4 __attribute__((ext_vector_type(4)));
typedef float f32x4 __attribute__((ext_vector_type(4)));
typedef float f32x16 __attribute__((ext_vector_type(16)));
typedef float f32x2 __attribute__((ext_vector_type(2)));
typedef unsigned u32x4 __attribute__((ext_vector_type(4)));
typedef unsigned u32x2 __attribute__((ext_vector_type(2)));
typedef __bf16 bf16x2_t __attribute__((ext_vector_type(2)));

constexpr int T = 8192, DM = 2048, INW = 2672, INWP = 2816, MLPH = 8192;
constexpr int MH = 8, QRANK = 512, KVRANK = 256, DQK = 192, MDV = 128;
constexpr int NG = 2, NHG = 8, NDK = 64;
constexpr float EPS = 1e-6f, LOG2E = 1.4426950408889634f;
constexpr float QS_MLA = 0.07216878364870322f * LOG2E;
constexpr float QS_NSA = 0.125f * LOG2E;
constexpr float NEGBIG = -1e30f;

constexpr size_t MiB = 1u << 20;
constexpr size_t WS_WDN = 0, WS_WUP = 32 * MiB, WS_WO = 64 * MiB, WS_WIN = 72 * MiB, WS_WUQ = 83 * MiB, WS_WUKV = 84 * MiB + 512 * 1024,
                 WS_W1K = 85 * MiB + 512 * 1024, WS_W1V = 86 * MiB + 512 * 1024;
constexpr size_t WS_XN = 88 * MiB;
constexpr size_t WS_CQ = 120 * MiB, WS_CKV = 128 * MiB, WS_KR = 132 * MiB, WS_QN = 134 * MiB, WS_KVC = 150 * MiB, WS_KVS = 154 * MiB,
                 WS_KVW = 158 * MiB, WS_GATE = 162 * MiB;
constexpr size_t WS_QM = 164 * MiB, WS_KM = 188 * MiB, WS_VM = 212 * MiB, WS_HIDK = 228 * MiB, WS_HIDV = 228 * MiB + 512 * 1024,
                 WS_KC = 229 * MiB, WS_VC = 229 * MiB + 128 * 1024;
constexpr size_t WS_U = 88 * MiB, WS_HB = 216 * MiB;
constexpr size_t WS_CTL = 248 * MiB, WS_COS = 249 * MiB, WS_SIN = 250 * MiB, WS_B1 = 251 * MiB, WS_SSQ2 = 252 * MiB, WS_SSQ3 = 253 * MiB,
                 WS_SSQQ = 254 * MiB, WS_SSQKV = 254 * MiB + 256 * 1024, WS_SSQM = 254 * MiB + 512 * 1024, WS_SSQN = 254 * MiB + 768 * 1024;
constexpr size_t WS_END = 256 * MiB;

constexpr int LDS_BYTES = 147456;

DI unsigned pk2(float lo, float hi) { f32x2 v = {lo, hi}; bf16x2_t b = __builtin_convertvector(v, bf16x2_t); return __builtin_bit_cast(unsigned, b); }
DI float bf2f(bf16_t b) { return __uint_as_float(((unsigned)b) << 16); }
DI u32x2 pk4(f32x4 v) { u32x2 r; r.x = pk2(v[0], v[1]); r.y = pk2(v[2], v[3]); return r; }
DI float wave_sum(float v) {
#pragma unroll
    for (int o = 1; o < 64; o <<= 1) v += __shfl_xor(v, o);
    return v;
}

namespace pg8 {
constexpr int BM = 256, BK = 64, HALF = 128, HTB = HALF * BK * 2, STAGE_BYTES = 8 * HTB;
DI int lds_byte(int r, int c) { const int st = (r >> 4) * 2 + (c >> 5), rr = r & 15, cc = c & 31, ob = rr * 64 + cc * 2; return st * 1024 + (ob ^ (((ob >> 9) & 1) << 5)); }
DI void stage_rc(int b, int& R, int& C) { const int st = b / 1024, sb = b % 1024, swz = sb ^ (((sb >> 9) & 1) << 5); R = (st >> 1) * 16 + swz / 64; C = (st & 1) * 32 + (swz % 64) / 2; }
struct Unit { int pm, pn, ko; };
struct Gemm { const bf16_t* A; const bf16_t* Bt; int lda, ldb, K; };

struct Order2 {
    int nM, ntot, G, c, kh;
    DI void init(int nM_, int nN_, int G_, int c_, int kh_) { nM = nM_; ntot = nM_ * nN_; G = G_; c = c_; kh = kh_; }
    DI bool next(int i, Unit& u) const { const int L = (i >> 1) * G + c; if (L >= ntot) return false; u.pm = L % nM; u.pn = L / nM; u.ko = (i & 1) * kh; return true; }
};
struct Order {
    int nM, ntot, G, c;
    DI void init(int nM_, int nN_, int G_, int c_) { nM = nM_; ntot = nM_ * nN_; G = G_; c = c_; }
    DI bool next(int i, Unit& u) const { const int L = i * G + c; if (L >= ntot) return false; u.pm = L % nM; u.pn = L / nM; u.ko = 0; return true; }
};

template <class Epi, class Sched>
DI void gemm_phase(LAS unsigned char* lds, const Gemm g, const Sched& S, const Epi& E) {
    int tid_ = threadIdx.x; asm volatile("" : "+v"(tid_));
    const int tid = tid_, wid = __builtin_amdgcn_readfirstlane(tid >> 6), lane = tid & 63, wr = wid >> 2, wc = wid & 3, fr = lane & 15, fq = lane >> 4;
    const int K = g.K, nt = K / BK;
    unsigned voffA[2], voffB[2];
#pragma unroll
    for (int i = 0; i < 2; ++i) { int R, C; stage_rc(tid * 16 + i * 8192, R, C);
        voffA[i] = (unsigned)(R * g.lda + C) * 2u; voffB[i] = (unsigned)(R * g.ldb + C) * 2u; }
    const size_t kstep = (size_t)(BK * 2);
    const size_t hstepA = (size_t)HALF * g.lda * 2, hstepB = (size_t)HALF * g.ldb * 2;
    const size_t tstepA = 2 * hstepA, tstepB = 2 * hstepB;
    const unsigned ldsw = (unsigned)wid * 1024u;
    const int aoff = lds_byte(wr * 64 + fr, fq * 8), boff = lds_byte(wc * 32 + fr, fq * 8);
#define PG8_SA(b, h) (((b) * 2 + (h)) * HTB)
#define PG8_SB(b, h) ((4 + (b) * 2 + (h)) * HTB)
#define PG8_STAGE(bufoff, gbase, voff) do { _Pragma("unroll") for (int _i = 0; _i < 2; ++_i) \
        __builtin_amdgcn_global_load_lds((const unsigned*)((const char*)(gbase) + (voff)[_i]), (LAS unsigned*)(lds + (bufoff) + ldsw + _i * 8192), 16, 0, 0); } while (0)
#define PG8_LDA(dst, b, h) do { _Pragma("unroll") for (int m = 0; m < 4; ++m) _Pragma("unroll") for (int k = 0; k < 2; ++k) dst[m][k] = *(const LAS bf16x8*)(lds + PG8_SA(b, h) + aoff + m * 2048 + k * 1024); } while (0)
#define PG8_LDB(dst, b, h) do { _Pragma("unroll") for (int n = 0; n < 2; ++n) _Pragma("unroll") for (int k = 0; k < 2; ++k) dst[n][k] = *(const LAS bf16x8*)(lds + PG8_SB(b, h) + boff + n * 2048 + k * 1024); } while (0)
#define PG8_MMA(ai, bj, At, Bt) do { __builtin_amdgcn_s_setprio(1); _Pragma("unroll") for (int m = 0; m < 4; ++m) _Pragma("unroll") for (int n = 0; n < 2; ++n) _Pragma("unroll") for (int k = 0; k < 2; ++k) \
        acc[ai][bj][m][n] = __builtin_amdgcn_mfma_f32_16x16x32_bf16(Bt[n][k], At[m][k], acc[ai][bj][m][n], 0, 0, 0); __builtin_amdgcn_s_setprio(0); } while (0)
#define PG8_WAIT_V(n) asm volatile("s_waitcnt vmcnt(" #n ")" ::: "memory")
#define PG8_WAIT_L(n) asm volatile("s_waitcnt lgkmcnt(" #n ")" ::: "memory")
#define PG8_BAR __builtin_amdgcn_s_barrier()
#define PG8_SCHED __builtin_amdgcn_sched_barrier(0)
    Unit cur, nxt; int ui = 0;
    if (!S.next(0, cur)) return;
    f32x4 acc[2][2][4][2];
#pragma unroll
    for (int a = 0; a < 2; ++a)
#pragma unroll
        for (int b = 0; b < 2; ++b)
#pragma unroll
            for (int m = 0; m < 4; ++m)
#pragma unroll
                for (int n = 0; n < 2; ++n) acc[a][b][m][n] = (f32x4){0.f, 0.f, 0.f, 0.f};
    bf16x8 At[4][2], B0[2][2], B1[2][2];
    const char* cA = (const char*)g.A + (size_t)cur.pm * tstepA + (size_t)cur.ko * 2; const char* cB = (const char*)g.Bt + (size_t)cur.pn * tstepB + (size_t)cur.ko * 2;
    PG8_STAGE(PG8_SB(0, 0), cB, voffB); PG8_STAGE(PG8_SB(0, 1), cB + hstepB, voffB); PG8_STAGE(PG8_SA(0, 0), cA, voffA); PG8_STAGE(PG8_SA(0, 1), cA + hstepA, voffA);
    if (wr == 1) PG8_BAR;
    PG8_WAIT_V(2); PG8_BAR;
    PG8_STAGE(PG8_SB(1, 0), cB + kstep, voffB); PG8_STAGE(PG8_SA(1, 0), cA + kstep, voffA); PG8_STAGE(PG8_SB(1, 1), cB + hstepB + kstep, voffB);
    PG8_WAIT_V(6); PG8_BAR;
    for (;;) {
        const bool has_next = S.next(ui + 1, nxt);
        const char* nA = has_next ? (const char*)g.A + (size_t)nxt.pm * tstepA + (size_t)nxt.ko * 2 : cA; const char* nB = has_next ? (const char*)g.Bt + (size_t)nxt.pn * tstepB + (size_t)nxt.ko * 2 : cB;
        for (int t = 0; t < nt; t += 2) {
            const bool last = (t == nt - 2);
            const char* a1 = cA + (size_t)(t + 1) * kstep;
            const char* a2 = last ? nA : cA + (size_t)(t + 2) * kstep; const char* b2 = last ? nB : cB + (size_t)(t + 2) * kstep;
            const char* a3 = a2 + kstep; const char* b3 = b2 + kstep;
            PG8_LDB(B0, 0, 0); PG8_LDB(B1, 0, 1); PG8_SCHED; PG8_LDA(At, 0, 0); PG8_STAGE(PG8_SA(1, 1), a1 + hstepA, voffA);
            PG8_WAIT_V(8); PG8_WAIT_L(0); PG8_BAR; PG8_MMA(0, 0, At, B0); PG8_MMA(0, 1, At, B1); PG8_BAR; PG8_SCHED;
            PG8_LDA(At, 0, 1); PG8_STAGE(PG8_SB(0, 0), b2, voffB); PG8_STAGE(PG8_SB(0, 1), b2 + hstepB, voffB); PG8_STAGE(PG8_SA(0, 0), a2, voffA);
            PG8_WAIT_V(8); PG8_WAIT_L(0); PG8_BAR; PG8_MMA(1, 0, At, B0); PG8_MMA(1, 1, At, B1); PG8_BAR; PG8_SCHED;
            PG8_LDB(B0, 1, 0); PG8_LDB(B1, 1, 1); PG8_SCHED; PG8_LDA(At, 1, 0); PG8_STAGE(PG8_SA(0, 1), a2 + hstepA, voffA);
            PG8_WAIT_V(8); PG8_WAIT_L(0); PG8_BAR; PG8_MMA(0, 0, At, B0); PG8_MMA(0, 1, At, B1); PG8_BAR; PG8_SCHED;
            PG8_LDA(At, 1, 1); PG8_STAGE(PG8_SB(1, 0), b3, voffB); PG8_STAGE(PG8_SB(1, 1), b3 + hstepB, voffB); PG8_STAGE(PG8_SA(1, 0), a3, voffA);
            PG8_WAIT_V(8); PG8_WAIT_L(0); PG8_BAR; PG8_MMA(1, 0, At, B0); PG8_MMA(1, 1, At, B1); PG8_BAR; PG8_SCHED;
        }
        if (wr == 0) PG8_BAR;
        E(acc, cur, wr, wc, fr, fq);
        if (!has_next) break;
#pragma unroll
        for (int a = 0; a < 2; ++a)
#pragma unroll
            for (int b = 0; b < 2; ++b)
#pragma unroll
                for (int m = 0; m < 4; ++m)
#pragma unroll
                    for (int n = 0; n < 2; ++n) acc[a][b][m][n] = (f32x4){0.f, 0.f, 0.f, 0.f};
        cur = nxt; cA = nA; cB = nB; ++ui;
        if (wr == 1) PG8_BAR;
    }
    PG8_WAIT_V(0);
    PG8_BAR;
#undef PG8_SA
#undef PG8_SB
#undef PG8_STAGE
#undef PG8_LDA
#undef PG8_LDB
#undef PG8_MMA
#undef PG8_WAIT_V
#undef PG8_WAIT_L
#undef PG8_BAR
#undef PG8_SCHED
}
}
using pg8::Unit;

#define EPI_ROWS(ri, row) _Pragma("unroll") for (int ai = 0; ai < 2; ++ai) _Pragma("unroll") for (int m = 0; m < 4; ++m) { const int ri = ai * 4 + m; const int row = u.pm * 256 + ai * 128 + wr * 64 + m * 16 + fr;
#define EPI_COLS(col, v) _Pragma("unroll") for (int bj = 0; bj < 2; ++bj) _Pragma("unroll") for (int n = 0; n < 2; ++n) { const int col = u.pn * 256 + bj * 128 + wc * 32 + n * 16 + fq * 4; f32x4& v = acc[ai][bj][m][n];
#define EPI_END }
typedef f32x4 Acc[2][2][4][2];

DI float dot4(f32x4 v) { return (v[0] * v[0] + v[1] * v[1]) + (v[2] * v[2] + v[3] * v[3]); }

struct EpiIn {
    static constexpr bool HAS_MID = false; int tmid;
    bf16_t *CQ, *CKV, *QN, *KVC, *KVS, *KVW; float *KR, *GATE, *SSQQ, *SSQKV;
    DI void mid(Acc&, const Unit&, int, int, int, int) const {}
    DI void operator()(Acc& acc, const Unit& u, int wr, int wc, int fr, int fq) const {
        EPI_ROWS(ri, row)
            EPI_COLS(col, v)
                if (col < 512) { *(u32x2*)(CQ + (size_t)row * 512 + col) = pk4(v); }
                else if (col < 768) { *(u32x2*)(CKV + (size_t)row * 256 + (col - 512)) = pk4(v); }
                else if (col < 832) { *(f32x4*)(KR + (size_t)row * 64 + (col - 768)) = v; }
                else if (col < 1856) { *(u32x2*)(QN + (size_t)row * 1024 + (col - 832)) = pk4(v * QS_NSA); }
                else if (col < 2624) { const int cc = col - 1856, kind = cc >> 8, c2 = cc & 255, g = c2 >> 7, d = c2 & 127, isv = d >> 6;
                    *(u32x2*)(KVC + (size_t)kind * (4 * MiB / 2) + ((size_t)(isv * 2 + g) * T + row) * 64 + (d & 63)) = pk4(v); }
                else if (col < 2672) { f32x4 s;
#pragma unroll
                    for (int j = 0; j < 4; ++j) s[j] = 1.f / (1.f + __expf(-v[j]));
                    *(f32x4*)(GATE + (size_t)row * 48 + (col - 2624)) = s; }
            EPI_END
        EPI_END
        if (u.pn <= 2) {
            EPI_ROWS(ri, row)
                float s = (dot4(acc[ai][0][m][0]) + dot4(acc[ai][0][m][1])) + (dot4(acc[ai][1][m][0]) + dot4(acc[ai][1][m][1]));
                s += __shfl_xor(s, 16); s += __shfl_xor(s, 32);
                if (fq == 0) { if (u.pn < 2) SSQQ[(size_t)row * 8 + u.pn * 4 + wc] = s; else SSQKV[(size_t)row * 4 + wc] = s; }
            EPI_END
        }
    }
};
struct EpiQ {
    static constexpr bool HAS_MID = false; int tmid;
    bf16_t* QM; const float *SSQQ, *COS, *SIN;
    DI void mid(Acc&, const Unit&, int, int, int, int) const {}
    DI void operator()(Acc& acc, const Unit& u, int wr, int wc, int fr, int fq) const {
        EPI_ROWS(ri, row)
            const f32x4 a = *(const f32x4*)(SSQQ + (size_t)row * 8), b = *(const f32x4*)(SSQQ + (size_t)row * 8 + 4);
            const float r = rsqrtf(((a[0] + a[1]) + (a[2] + a[3]) + (b[0] + b[1]) + (b[2] + b[3])) * (1.f / 512.f) + EPS);
            EPI_COLS(col, v)
                const int h = col / 192, p = col - h * 192;
                f32x4 x = v * r;
                if (p >= 128) { const int i = (p - 128) >> 1;
                    const f32x2 c = *(const f32x2*)(COS + (size_t)row * 32 + i), s = *(const f32x2*)(SIN + (size_t)row * 32 + i);
                    f32x4 o; o[0] = x[0] * c[0] - x[1] * s[0]; o[1] = x[1] * c[0] + x[0] * s[0]; o[2] = x[2] * c[1] - x[3] * s[1]; o[3] = x[3] * c[1] + x[2] * s[1]; x = o; }
                *(u32x2*)(QM + (size_t)row * 1536 + col) = pk4(x * QS_MLA);
            EPI_END
        EPI_END
    }
};
struct EpiKV {
    static constexpr bool HAS_MID = false; int tmid;
    bf16_t *KM, *VM; const float* SSQKV;
    DI void mid(Acc&, const Unit&, int, int, int, int) const {}
    DI void operator()(Acc& acc, const Unit& u, int wr, int wc, int fr, int fq) const {
        EPI_ROWS(ri, row)
            const f32x4 a = *(const f32x4*)(SSQKV + (size_t)row * 4);
            const float r = rsqrtf(((a[0] + a[1]) + (a[2] + a[3])) * (1.f / 256.f) + EPS);
            EPI_COLS(col, v)
                const int h = col >> 8, d = col & 255;
                const u32x2 w = pk4(v * r);
                if (d < 128) *(u32x2*)(KM + (size_t)row * 1536 + h * 192 + d) = w;
                else *(u32x2*)(VM + (size_t)row * 1024 + h * 128 + (d - 128)) = w;
            EPI_END
        EPI_END
    }
};
DI float gelu_tanh(float x) { const float z = 0.7978845608028654f * (x + 0.044715f * x * x * x); const float e = __expf(2.f * z); const float th = 1.f - 2.f / (e + 1.f); return 0.5f * x * (1.f + th); }
struct EpiHid {
    static constexpr bool HAS_MID = false; int tmid;
    bf16_t* HID; const float* B1;
    DI void mid(Acc&, const Unit&, int, int, int, int) const {}
    DI void operator()(Acc& acc, const Unit& u, int wr, int wc, int fr, int fq) const {
        EPI_ROWS(ri, row)
            EPI_COLS(col, v)
                const f32x4 b = *(const f32x4*)(B1 + col); f32x4 o;
#pragma unroll
                for (int j = 0; j < 4; ++j) o[j] = gelu_tanh(v[j] + b[j]);
                *(u32x2*)(HID + (size_t)row * 256 + col) = pk4(o);
            EPI_END
        EPI_END
    }
};
struct EpiO {
    static constexpr bool HAS_MID = false; int tmid;
    const float *X, *SSQM, *SSQN; float *H, *SSQ2; bf16_t* HB;
    DI void mid(Acc&, const Unit&, int, int, int, int) const {}
    DI void operator()(Acc& acc, const Unit& u, int wr, int wc, int fr, int fq) const {
        if (u.ko == 0) {
            EPI_ROWS(ri, row)
                const f32x4 a = *(const f32x4*)(SSQM + (size_t)row * 8), b = *(const f32x4*)(SSQM + (size_t)row * 8 + 4);
                const float rm = rsqrtf(((a[0] + a[1]) + (a[2] + a[3]) + (b[0] + b[1]) + (b[2] + b[3])) * (1.f / 1024.f) + EPS);
                EPI_COLS(col, v)
                    const f32x4 x = *(const f32x4*)(X + (size_t)row * DM + col);
                    *(f32x4*)(H + (size_t)row * DM + col) = x + v * rm;
                EPI_END
                asm volatile("" ::: "memory");
            EPI_END
        } else {
            EPI_ROWS(ri, row)
                const f32x2 c = *(const f32x2*)(SSQN + (size_t)row * 2);
                const float rn = rsqrtf((c[0] + c[1]) * (1.f / 1024.f) + EPS); float ss = 0.f;
                EPI_COLS(col, v)
                    const f32x4 h = *(const f32x4*)(H + (size_t)row * DM + col) + v * rn;
                    *(f32x4*)(H + (size_t)row * DM + col) = h; *(u32x2*)(HB + (size_t)row * DM + col) = pk4(h); ss += dot4(h);
                EPI_END
                ss += __shfl_xor(ss, 16); ss += __shfl_xor(ss, 32);
                if (fq == 0) SSQ2[(size_t)row * 32 + u.pn * 4 + wc] = ss;
                asm volatile("" ::: "memory");
            EPI_END
        }
    }
};
DI float sum32(const float* p) { float s = 0.f;
#pragma unroll
    for (int j = 0; j < 8; ++j) { const f32x4 a = *(const f32x4*)(p + 4 * j); s += (a[0] + a[1]) + (a[2] + a[3]); }
    return s; }
struct EpiUp {
    static constexpr bool HAS_MID = false; int tmid;
    const float* SSQ2; bf16_t* U;
    DI void mid(Acc&, const Unit&, int, int, int, int) const {}
    DI void operator()(Acc& acc, const Unit& u, int wr, int wc, int fr, int fq) const {
        EPI_ROWS(ri, row)
            const float r = rsqrtf(sum32(SSQ2 + (size_t)row * 32) * (1.f / 2048.f) + EPS);
            EPI_COLS(col, v)
                f32x4 o;
#pragma unroll
                for (int j = 0; j < 4; ++j) { const float a = fmaxf(v[j] * r, 0.f); o[j] = a * a; }
                *(u32x2*)(U + (size_t)row * MLPH + col) = pk4(o);
            EPI_END
        EPI_END
    }
};
struct EpiDown {
    static constexpr bool HAS_MID = false; int tmid;
    float *H, *SSQ3;
    DI void mid(Acc&, const Unit&, int, int, int, int) const {}
    DI void operator()(Acc& acc, const Unit& u, int wr, int wc, int fr, int fq) const {
        EPI_ROWS(ri, row)
            float ss = 0.f;
            EPI_COLS(col, v)
                const f32x4 o = *(const f32x4*)(H + (size_t)row * DM + col) + v;
                *(f32x4*)(H + (size_t)row * DM + col) = o; ss += dot4(o);
            EPI_END
            ss += __shfl_xor(ss, 16); ss += __shfl_xor(ss, 32);
            if (fq == 0) SSQ3[(size_t)row * 32 + u.pn * 4 + wc] = ss;
        EPI_END
    }
};

struct Params {
    const float *x, *attn_norm_w, *w_in, *mla_q_norm_w, *mla_w_uq, *mla_kv_norm_w, *mla_w_ukv, *cmp_pos_k, *cmp_pos_v, *cmp_w1_k, *cmp_w2_k,
        *cmp_w1_v, *cmp_w2_v, *mla_out_norm_w, *nsa_out_norm_w, *w_o, *mlp_norm_w, *w_up, *w_down, *final_norm_w;
    const int* positions;
    float* out; unsigned char* ws;
};

template <class RowMap>
DI void transpose_item(const float* W, int K, int N, bf16_t* WT, const float* kscale, const float* kscale2, int ksplit, LAS float* scr, int item, int lane, RowMap rowmap) {
    const int nblk = (N + 31) / 32, kb = item / nblk, nb = item % nblk, k0 = 64 * kb, n0 = 32 * nb;
    const int nn = n0 + (lane & 31);
#pragma unroll 8
    for (int i = 0; i < 32; ++i) { const int kk = 2 * i + (lane >> 5); const int k = k0 + kk;
        float v = nn < N ? W[(size_t)k * N + nn] : 0.f;
        if (kscale) v *= (k < ksplit ? kscale[k] : kscale2[k - ksplit]);
        scr[kk * 33 + (lane & 31)] = v; }
    asm volatile("s_waitcnt lgkmcnt(0)" ::: "memory");
    const int c = lane & 7;
#pragma unroll
    for (int j = 0; j < 4; ++j) { const int n = (lane >> 3) + 8 * j; const LAS float* s = scr + (8 * c) * 33 + n;
        u32x4 o; o.x = pk2(s[0 * 33], s[1 * 33]); o.y = pk2(s[2 * 33], s[3 * 33]); o.z = pk2(s[4 * 33], s[5 * 33]); o.w = pk2(s[6 * 33], s[7 * 33]);
        if (n0 + n < N) *(u32x4*)(WT + (size_t)rowmap(n0 + n) * K + k0 + 8 * c) = o; }
    asm volatile("s_waitcnt lgkmcnt(0)" ::: "memory");
}
struct RowId { DI int operator()(int n) const { return n; } };
struct RowUq { DI int operator()(int n) const { const int h = n / 192, d = n - h * 192; if (d < 128) return n; const int i = d - 128; return h * 192 + 128 + (i < 32 ? 2 * i : 2 * (i - 32) + 1); } };

DI void sincos_acc(float a, float& sn, float& cs) {
    const double ad = (double)a;
    const double q = __builtin_rint(ad * 0.6366197723675814);
    const double r = (ad - q * 1.5707963267948966) - q * 6.123233995736766e-17;
    const double r2 = r * r;
    const double sp = r * (1.0 + r2 * (-1.0 / 6 + r2 * (1.0 / 120 + r2 * (-1.0 / 5040 + r2 * (1.0 / 362880 + r2 * (-1.0 / 39916800))))));
    const double cp = 1.0 + r2 * (-0.5 + r2 * (1.0 / 24 + r2 * (-1.0 / 720 + r2 * (1.0 / 40320 + r2 * (-1.0 / 3628800 + r2 * (1.0 / 479001600))))));
    const int qi = ((int)q) & 3;
    const double s = (qi == 0) ? sp : (qi == 1) ? cp : (qi == 2) ? -sp : -cp;
    const double c = (qi == 0) ? cp : (qi == 1) ? -sp : (qi == 2) ? -cp : sp;
    sn = (float)s; cs = (float)c;
}

DI void p0_prep(const Params& P, LAS unsigned char* lds, int G) {
    const int tid = threadIdx.x, lane = tid & 63, wave = __builtin_amdgcn_readfirstlane(tid >> 6);
    LAS float* scr = (LAS float*)(lds + wave * 16384);
    const int gw = blockIdx.x * 8 + wave, NGW = G * 8;
    unsigned char* ws = P.ws;
    bf16_t* Win_t = (bf16_t*)(ws + WS_WIN); bf16_t* Wuq_t = (bf16_t*)(ws + WS_WUQ); bf16_t* Wukv_t = (bf16_t*)(ws + WS_WUKV);
    bf16_t* W1k_t = (bf16_t*)(ws + WS_W1K); bf16_t* W1v_t = (bf16_t*)(ws + WS_W1V); bf16_t* Wo_t = (bf16_t*)(ws + WS_WO);
    bf16_t* Wup_t = (bf16_t*)(ws + WS_WUP); bf16_t* Wdn_t = (bf16_t*)(ws + WS_WDN);
    constexpr int I_IN = (DM / 64) * ((INW + 31) / 32), I_UQ = (QRANK / 64) * (1536 / 32), I_UKV = (KVRANK / 64) * (2048 / 32), I_W1 = (2048 / 64) * (256 / 32),
                  I_O = (DM / 64) * (DM / 32), I_UP = (DM / 64) * (MLPH / 32), I_DN = (MLPH / 64) * (DM / 32);
    constexpr int NITEMS = I_IN + I_UQ + I_UKV + 2 * I_W1 + I_O + I_UP + I_DN;
    for (int it = gw; it < NITEMS; it += NGW) {
        int r = it;
        if (r < I_UP) { transpose_item(P.w_up, DM, MLPH, Wup_t, P.mlp_norm_w, P.mlp_norm_w, DM, scr, r, lane, RowId()); continue; } r -= I_UP;
        if (r < I_DN) { transpose_item(P.w_down, MLPH, DM, Wdn_t, nullptr, nullptr, 0, scr, r, lane, RowId()); continue; } r -= I_DN;
        if (r < I_IN) { transpose_item(P.w_in, DM, INW, Win_t, nullptr, nullptr, 0, scr, r, lane, RowId()); continue; } r -= I_IN;
        if (r < I_O) { transpose_item(P.w_o, DM, DM, Wo_t, P.mla_out_norm_w, P.nsa_out_norm_w, 1024, scr, r, lane, RowId()); continue; } r -= I_O;
        if (r < I_UQ) { transpose_item(P.mla_w_uq, QRANK, 1536, Wuq_t, P.mla_q_norm_w, P.mla_q_norm_w, QRANK, scr, r, lane, RowUq()); continue; } r -= I_UQ;
        if (r < I_UKV) { transpose_item(P.mla_w_ukv, KVRANK, 2048, Wukv_t, P.mla_kv_norm_w, P.mla_kv_norm_w, KVRANK, scr, r, lane, RowId()); continue; } r -= I_UKV;
        if (r < I_W1) { transpose_item(P.cmp_w1_k, 2048, 256, W1k_t, nullptr, nullptr, 0, scr, r, lane, RowId()); continue; } r -= I_W1;
        transpose_item(P.cmp_w1_v, 2048, 256, W1v_t, nullptr, nullptr, 0, scr, r, lane, RowId());
    }
    bf16_t* XN = (bf16_t*)(ws + WS_XN);
    for (int row = gw; row < T; row += NGW) {
        const f32x4* xr = (const f32x4*)(P.x + (size_t)row * DM) + lane;
        f32x4 v[8]; float s = 0.f;
#pragma unroll
        for (int j = 0; j < 8; ++j) { v[j] = xr[64 * j]; s += dot4(v[j]); }
        const float r = rsqrtf(wave_sum(s) * (1.f / DM) + EPS);
#pragma unroll
        for (int j = 0; j < 8; ++j) { const f32x4 w = *((const f32x4*)P.attn_norm_w + lane + 64 * j);
            *(u32x2*)(XN + (size_t)row * DM + (lane + 64 * j) * 4) = pk4(v[j] * r * w); }
    }
    const int gt = blockIdx.x * 512 + tid, NGT = G * 512;
    for (int i = gt; i < (INWP - INW) * DM / 8; i += NGT) *(u32x4*)(Win_t + (size_t)INW * DM + (size_t)i * 8) = (u32x4){0u, 0u, 0u, 0u};
    float* COS = (float*)(ws + WS_COS); float* SIN = (float*)(ws + WS_SIN);
    for (int i = gt; i < T * 32; i += NGT) { const int t = i >> 5, j = i & 31;
        const float ex = (float)(2 * j) / 64.0f;
        const float pw = (float)exp((double)ex * 9.210340371976184);
        const float inv = 1.0f / pw;
        const float ang = (float)P.positions[t] * inv;
        float sn, cs; sincos_acc(ang, sn, cs); COS[i] = cs; SIN[i] = sn; }
    float* B1 = (float*)(ws + WS_B1);
    for (int i = gt; i < 512; i += NGT) { const int kv = i >> 8, n = i & 255; const float* pos = kv ? P.cmp_pos_v : P.cmp_pos_k; const float* w1 = kv ? P.cmp_w1_v : P.cmp_w1_k;
        float s = 0.f; for (int k = 0; k < 2048; ++k) s += pos[k] * w1[(size_t)k * 256 + n]; B1[i] = s; }
}

DI f32x16 mfma32(bf16x8 a, bf16x8 b, f32x16 c) { return __builtin_amdgcn_mfma_f32_32x32x16_bf16(a, b, c, 0, 0, 0); }
typedef short v4i16_t __attribute__((ext_vector_type(4)));
DI s16x4 vtr(const LAS char* p) { return __builtin_bit_cast(s16x4, __builtin_amdgcn_ds_read_tr16_b64_v4i16((LAS v4i16_t*)p)); }
DI int crow(int r, int hi) { return (r & 3) + 8 * (r >> 2) + 4 * hi; }
#define CR(r) (((r) & 3) + 8 * ((r) >> 2))

template <int NKS, int PKB>
DI void qk_tile(const LAS char* Kt, const bf16x8* qf, int r32, int hi, f32x16& s0, f32x16& s1) {
    const LAS char* kb = Kt + r32 * PKB + hi * 16;
#pragma unroll
    for (int ks = 0; ks < NKS; ++ks) {
        const bf16x8 a0 = *(const LAS bf16x8*)(kb + ks * 32);
        const bf16x8 a1 = *(const LAS bf16x8*)(kb + 32 * PKB + ks * 32);
        s0 = mfma32(a0, qf[ks], s0); s1 = mfma32(a1, qf[ks], s1);
    }
}
template <int ND0, int PVB>
DI void pv_tile(const LAS char* Vt, const f32x16& p0, const f32x16& p1, f32x16* o, int lane) {
    const int hi = lane >> 5, q = (lane & 15) >> 2, p = lane & 3, blk = (lane >> 4) & 1;
    const LAS char* vb = Vt + (4 * hi + q) * PVB + (16 * blk + 4 * p) * 2;
    bf16x8 pa[4];
    { u32x4 w;
      w.x = pk2(p0[0], p0[1]); w.y = pk2(p0[2], p0[3]); w.z = pk2(p0[4], p0[5]); w.w = pk2(p0[6], p0[7]); pa[0] = __builtin_bit_cast(bf16x8, w);
      w.x = pk2(p0[8], p0[9]); w.y = pk2(p0[10], p0[11]); w.z = pk2(p0[12], p0[13]); w.w = pk2(p0[14], p0[15]); pa[1] = __builtin_bit_cast(bf16x8, w);
      w.x = pk2(p1[0], p1[1]); w.y = pk2(p1[2], p1[3]); w.z = pk2(p1[4], p1[5]); w.w = pk2(p1[6], p1[7]); pa[2] = __builtin_bit_cast(bf16x8, w);
      w.x = pk2(p1[8], p1[9]); w.y = pk2(p1[10], p1[11]); w.z = pk2(p1[12], p1[13]); w.w = pk2(p1[14], p1[15]); pa[3] = __builtin_bit_cast(bf16x8, w); }
#pragma unroll
    for (int d0 = 0; d0 < ND0; ++d0) {
#pragma unroll
        for (int kk = 0; kk < 4; ++kk) {
            const s16x4 lo = vtr(vb + (16 * kk) * PVB + d0 * 64);
            const s16x4 hh = vtr(vb + (16 * kk + 8) * PVB + d0 * 64);
            const bf16x8 vf = (bf16x8){lo[0], lo[1], lo[2], lo[3], hh[0], hh[1], hh[2], hh[3]};
            o[d0] = mfma32(pa[kk], vf, o[d0]);
        }
        __builtin_amdgcn_sched_barrier(0);
    }
}
DI float rowmax32(const f32x16& s0, const f32x16& s1) {
    float a = fmaxf(s0[0], s1[0]);
#pragma unroll
    for (int r = 1; r < 16; ++r) a = fmaxf(a, fmaxf(s0[r], s1[r]));
    return fmaxf(a, __shfl_xor(a, 32));
}
template <int ND0>
DI void online_update(f32x16& s0, f32x16& s1, float& m, float& l, f32x16* o, LAS float* wsf, int r32, int hi) {
    const float mx = rowmax32(s0, s1);
    const float mnew = fmaxf(m, mx);
    const float alpha = __builtin_amdgcn_exp2f(m - mnew);
    if constexpr (ND0 > 0) {
        if (__any(mnew > m)) {
            if (hi == 0) wsf[r32] = alpha;
            asm volatile("s_waitcnt lgkmcnt(0)" ::: "memory");
#pragma unroll
            for (int r = 0; r < 16; ++r) { const float a = wsf[crow(r, hi)];
#pragma unroll
                for (int d = 0; d < ND0; ++d) o[d][r] *= a; }
            asm volatile("s_waitcnt lgkmcnt(0)" ::: "memory");
        }
    }
    m = mnew;
    float ls = 0.f;
#pragma unroll
    for (int r = 0; r < 16; ++r) { s0[r] = __builtin_amdgcn_exp2f(s0[r] - mnew); s1[r] = __builtin_amdgcn_exp2f(s1[r] - mnew); ls += s0[r] + s1[r]; }
    l = l * alpha + ls;
}

constexpr int MLA_PK = 400, MLA_PV = 320, MLA_KB = 64 * MLA_PK, MLA_VB = 64 * MLA_PV;
constexpr int MLA_WS = 2 * MLA_KB + 2 * MLA_VB;
DI void mla_unit(const Params& P, LAS unsigned char* lds, int h, int qb) {
    int tid_ = threadIdx.x; asm volatile("" : "+v"(tid_));
    const int tid = tid_, lane = tid & 63, wave = __builtin_amdgcn_readfirstlane(tid >> 6), r32 = lane & 31, hi = lane >> 5;
    const bf16_t* QM = (const bf16_t*)(P.ws + WS_QM); const bf16_t* KM = (const bf16_t*)(P.ws + WS_KM); const bf16_t* VM = (const bf16_t*)(P.ws + WS_VM);
    bf16_t* Y = (bf16_t*)(P.ws + WS_XN); float* SSQM = (float*)(P.ws + WS_SSQM);
    LAS float* wsf = (LAS float*)(lds + MLA_WS + wave * 256);
    const int q0 = qb * 256 + wave * 32;
    bf16x8 qf[12];
    { const bf16_t* qp = QM + (size_t)(q0 + r32) * 1536 + h * 192 + hi * 8;
#pragma unroll
      for (int ks = 0; ks < 12; ++ks) qf[ks] = *(const bf16x8*)(qp + ks * 16); }
    f32x16 o[4];
#pragma unroll
    for (int d = 0; d < 4; ++d)
#pragma unroll
        for (int r = 0; r < 16; ++r) o[d][r] = 0.f;
    float m = NEGBIG, l = 0.f;
    const int NT = 4 * qb + 4;
    int krow[3], kch[3], vrow[2], vch[2];
#pragma unroll
    for (int i = 0; i < 3; ++i) { const int idx = tid + 512 * i; krow[i] = idx / 24; kch[i] = idx - krow[i] * 24; }
#pragma unroll
    for (int i = 0; i < 2; ++i) { const int idx = tid + 512 * i; vrow[i] = idx >> 4; vch[i] = idx & 15; }
    u32x4 kreg[3], vreg[2];
#define MLA_LOAD(t) do { _Pragma("unroll") for (int i = 0; i < 3; ++i) kreg[i] = *(const u32x4*)(KM + (size_t)((t) * 64 + krow[i]) * 1536 + h * 192 + kch[i] * 8); \
                         _Pragma("unroll") for (int i = 0; i < 2; ++i) vreg[i] = *(const u32x4*)(VM + (size_t)((t) * 64 + vrow[i]) * 1024 + h * 128 + vch[i] * 8); } while (0)
#define MLA_WRITE(b) do { _Pragma("unroll") for (int i = 0; i < 3; ++i) *(LAS u32x4*)(lds + (b) * MLA_KB + krow[i] * MLA_PK + kch[i] * 16) = kreg[i]; \
                          _Pragma("unroll") for (int i = 0; i < 2; ++i) *(LAS u32x4*)(lds + 2 * MLA_KB + (b) * MLA_VB + vrow[i] * MLA_PV + vch[i] * 16) = vreg[i]; } while (0)
    MLA_LOAD(0); MLA_WRITE(0);
    __syncthreads();
    for (int t = 0; t < NT; ++t) {
        const int b = t & 1;
        if (t + 1 < NT) MLA_LOAD(t + 1);
        const int k0 = t * 64;
        if (k0 <= q0 + 31) {
            f32x16 s0, s1;
#pragma unroll
            for (int r = 0; r < 16; ++r) { s0[r] = 0.f; s1[r] = 0.f; }
            qk_tile<12, MLA_PK>((const LAS char*)(lds + b * MLA_KB), qf, r32, hi, s0, s1);
            if (k0 + 63 > q0) {
                const int d0 = q0 + r32 - k0 - 4 * hi;
#pragma unroll
                for (int r = 0; r < 16; ++r) { if (CR(r) > d0) s0[r] = NEGBIG; if (CR(r) + 32 > d0) s1[r] = NEGBIG; }
            }
            online_update<4>(s0, s1, m, l, o, wsf, r32, hi);
            pv_tile<4, MLA_PV>((const LAS char*)(lds + 2 * MLA_KB + b * MLA_VB), s0, s1, o, lane);
        }
        if (t + 1 < NT) MLA_WRITE(b ^ 1);
        __syncthreads();
    }
#undef MLA_LOAD
#undef MLA_WRITE
    const float lt = l + __shfl_xor(l, 32);
    if (hi == 0) wsf[r32] = 1.f / lt;
    asm volatile("s_waitcnt lgkmcnt(0)" ::: "memory");
#pragma unroll
    for (int r = 0; r < 16; ++r) {
        const int row = crow(r, hi); const float il = wsf[row]; float ss = 0.f;
#pragma unroll
        for (int d = 0; d < 4; ++d) { const float y = o[d][r] * il; ss += y * y;
            Y[(size_t)(q0 + row) * DM + h * 128 + d * 32 + r32] = (bf16_t)(pk2(y, 0.f) & 0xffffu); }
#pragma unroll
        for (int off = 1; off < 32; off <<= 1) ss += __shfl_xor(ss, off);
        if (r32 == 0) SSQM[(size_t)(q0 + row) * 8 + h] = ss;
    }
    __syncthreads();
}

constexpr int NSA_PK = 144, NSA_PV = 192, NSA_KB = 64 * NSA_PK, NSA_VB = 64 * NSA_PV;
constexpr int NSA_WS = NSA_KB + NSA_VB;
constexpr int NSA_WSZ = 4608;
constexpr int NSA_BU = NSA_WS + 8 * NSA_WSZ;

DI void nsa_stage(LAS unsigned char* lds, const bf16_t* Ks, const bf16_t* Vs, int tid) {
    const int row = tid >> 3, ch = tid & 7;
    const u32x4 kv = *(const u32x4*)(Ks + row * 64 + ch * 8), vv = *(const u32x4*)(Vs + row * 64 + ch * 8);
    *(LAS u32x4*)(lds + row * NSA_PK + ch * 16) = kv; *(LAS u32x4*)(lds + NSA_KB + row * NSA_PV + ch * 16) = vv;
}
DI void nsa_bias(f32x16& s0, f32x16& s1, float c0, float c1, float slc) {
    asm volatile("" : "+v"(slc));
#pragma unroll
    for (int r = 0; r < 16; ++r) { const float b = slc * (float)CR(r); s0[r] += c0 + b; s1[r] += c1 + b; }
}

DI void nsa_unit(const Params& P, LAS unsigned char* lds, int tile, int g) {
    int tid_ = threadIdx.x; asm volatile("" : "+v"(tid_));
    const int tid = tid_, lane = tid & 63, wave = __builtin_amdgcn_readfirstlane(tid >> 6), r32 = lane & 31, hi = lane >> 5;
    const unsigned char* ws = P.ws;
    const bf16_t* QN = (const bf16_t*)(ws + WS_QN);
    const bf16_t* KC = (const bf16_t*)(ws + WS_KC) + (size_t)g * 512 * 64; const bf16_t* VC = (const bf16_t*)(ws + WS_VC) + (size_t)g * 512 * 64;
    const bf16_t* KS = (const bf16_t*)(ws + WS_KVS) + (size_t)g * T * 64; const bf16_t* VS = (const bf16_t*)(ws + WS_KVS) + (size_t)(2 + g) * T * 64;
    const bf16_t* KW = (const bf16_t*)(ws + WS_KVW) + (size_t)g * T * 64; const bf16_t* VW = (const bf16_t*)(ws + WS_KVW) + (size_t)(2 + g) * T * 64;
    const float* GATE = (const float*)(ws + WS_GATE);
    bf16_t* Y = (bf16_t*)(P.ws + WS_XN); float* SSQN = (float*)(P.ws + WS_SSQN);
    LAS unsigned char* wsb = lds + NSA_WS + wave * NSA_WSZ;
    LAS float* wsf = (LAS float*)wsb; LAS unsigned* selm = (LAS unsigned*)(wsb + 128); LAS float* AE = (LAS float*)(wsb + 512);
    LAS unsigned* BU = (LAS unsigned*)(lds + NSA_BU);
    const LAS char* Kt = (const LAS char*)lds; const LAS char* Vt = (const LAS char*)(lds + NSA_KB);

    const int t0 = tile * 32, cur = t0 >> 6;
    const int tokl = r32 >> 3, head = r32 & 7, hidx = g * 8 + head;
    const int t = t0 + wave * 4 + tokl;
    const float sl2 = __builtin_amdgcn_exp2f(-0.5f * (float)(hidx + 1)) * LOG2E;
    bf16x8 qf[4];
    { const bf16_t* qp = QN + (size_t)t * 1024 + hidx * 64 + hi * 8;
#pragma unroll
      for (int ks = 0; ks < 4; ++ks) qf[ks] = *(const bf16x8*)(qp + ks * 16); }
    if (tid < 4) BU[tid] = 0u;
    f32x16 yacc[2];
#pragma unroll
    for (int d = 0; d < 2; ++d)
#pragma unroll
        for (int r = 0; r < 16; ++r) yacc[d][r] = 0.f;
    const float gc = GATE[(size_t)t * 48 + hidx * 3 + 0], gs = GATE[(size_t)t * 48 + hidx * 3 + 1], gw = GATE[(size_t)t * 48 + hidx * 3 + 2];

    const int ntc = ((t0 >> 4) + 1 + 63) >> 6;
    float mc = NEGBIG, lc = 0.f;
    for (int i = 0; i < ntc; ++i) {
        const int n0 = 64 * i;
        __syncthreads();
        nsa_stage(lds, KC + (size_t)n0 * 64, VC + (size_t)n0 * 64, tid);
        __syncthreads();
        f32x16 s0, s1;
#pragma unroll
        for (int r = 0; r < 16; ++r) { s0[r] = 0.f; s1[r] = 0.f; }
        qk_tile<4, NSA_PK>(Kt, qf, r32, hi, s0, s1);
        const int db = t - 31 - 16 * (n0 + 4 * hi);
        nsa_bias(s0, s1, -sl2 * (float)db, -sl2 * (float)(db - 512), sl2 * 16.f);
        if (16 * (n0 + 63) + 31 > t0) {
#pragma unroll
            for (int r = 0; r < 16; ++r) { if (16 * CR(r) > db) s0[r] = NEGBIG; if (16 * CR(r) + 512 > db) s1[r] = NEGBIG; }
        }
        online_update<0>(s0, s1, mc, lc, nullptr, wsf, r32, hi);
    }
    const float lct = lc + __shfl_xor(lc, 32);
    const float ilc = (t >= 31) ? 1.f / lct : 0.f;
    f32x16 oc[2];
#pragma unroll
    for (int d = 0; d < 2; ++d)
#pragma unroll
        for (int r = 0; r < 16; ++r) oc[d][r] = 0.f;
    for (int i = 0; i < ntc; ++i) {
        const int n0 = 64 * i;
        __syncthreads();
        nsa_stage(lds, KC + (size_t)n0 * 64, VC + (size_t)n0 * 64, tid);
        __syncthreads();
        f32x16 s0, s1;
#pragma unroll
        for (int r = 0; r < 16; ++r) { s0[r] = 0.f; s1[r] = 0.f; }
        qk_tile<4, NSA_PK>(Kt, qf, r32, hi, s0, s1);
        const int db = t - 31 - 16 * (n0 + 4 * hi);
        nsa_bias(s0, s1, -sl2 * (float)db, -sl2 * (float)(db - 512), sl2 * 16.f);
        if (16 * (n0 + 63) + 31 > t0) {
#pragma unroll
            for (int r = 0; r < 16; ++r) { if (16 * CR(r) > db) s0[r] = NEGBIG; if (16 * CR(r) + 512 > db) s1[r] = NEGBIG; }
        }
#pragma unroll
        for (int r = 0; r < 16; ++r) { s0[r] = __builtin_amdgcn_exp2f(s0[r] - mc) * ilc; s1[r] = __builtin_amdgcn_exp2f(s1[r] - mc) * ilc; }
#pragma unroll
        for (int kh = 0; kh < 2; ++kh)
#pragma unroll
            for (int qd = 0; qd < 4; ++qd) {
                const f32x16& s = kh ? s1 : s0;
                float a = (s[4 * qd] + s[4 * qd + 1]) + (s[4 * qd + 2] + s[4 * qd + 3]); float e = s[4 * qd + 3];
                a += __shfl_xor(a, 1); e += __shfl_xor(e, 1); a += __shfl_xor(a, 2); e += __shfl_xor(e, 2); a += __shfl_xor(a, 4); e += __shfl_xor(e, 4);
                if (head == 0) { const int blk = 16 * i + 8 * kh + 2 * qd + hi; AE[tokl * 128 + blk] = a; AE[512 + tokl * 128 + blk] = e; }
            }
        pv_tile<2, NSA_PV>(Vt, s0, s1, oc, lane);
    }
    if (hi == 0) wsf[r32] = gc;
    asm volatile("s_waitcnt lgkmcnt(0)" ::: "memory");
#pragma unroll
    for (int r = 0; r < 16; ++r) { const float a = wsf[crow(r, hi)]; yacc[0][r] += oc[0][r] * a; yacc[1][r] += oc[1][r] * a; }
    asm volatile("s_waitcnt lgkmcnt(0)" ::: "memory");

    unsigned wu0 = 0u, wu1 = 0u, wu2 = 0u, wu3 = 0u;
#pragma unroll 1
    for (int tk = 0; tk < 4; ++tk) {
        unsigned mk0 = 0u, mk1 = 0u, mk2 = 0u, mk3 = 0u;
        if (cur < 16) { mk0 = (cur == 31) ? 0xffffffffu : ((2u << cur) - 1u); }
        else {
            mk0 = 1u;
            { const int b = cur; if (b < 32) mk0 |= 1u << b; else if (b < 64) mk1 |= 1u << (b - 32); else if (b < 96) mk2 |= 1u << (b - 64); else mk3 |= 1u << (b - 96); }
            { const int b = cur - 1; if (b < 32) mk0 |= 1u << b; else if (b < 64) mk1 |= 1u << (b - 32); else if (b < 96) mk2 |= 1u << (b - 64); else mk3 |= 1u << (b - 96); }
            float v0 = -1.f, v1 = -1.f;
            { const int s = lane; if (s >= 1 && s <= cur - 2) v0 = AE[tk * 128 + s] + AE[512 + tk * 128 + s - 1]; }
            { const int s = lane + 64; if (s <= cur - 2) v1 = AE[tk * 128 + s] + AE[512 + tk * 128 + s - 1]; }
#pragma unroll 1
            for (int it = 0; it < 13; ++it) {
                float mv = fmaxf(v0, v1);
#pragma unroll
                for (int off = 32; off >= 1; off >>= 1) mv = fmaxf(mv, __shfl_xor(mv, off));
                const unsigned long long b0 = __ballot(v0 == mv), b1 = __ballot(v1 == mv);
                const int idx = b0 ? (__ffsll((long long)b0) - 1) : (64 + __ffsll((long long)b1) - 1);
                if (lane == (idx & 63)) { if (idx < 64) v0 = -1.f; else v1 = -1.f; }
                if (idx < 32) mk0 |= 1u << idx; else if (idx < 64) mk1 |= 1u << (idx - 32); else if (idx < 96) mk2 |= 1u << (idx - 64); else mk3 |= 1u << (idx - 96);
            }
        }
        mk0 = __builtin_amdgcn_readfirstlane(mk0); mk1 = __builtin_amdgcn_readfirstlane(mk1); mk2 = __builtin_amdgcn_readfirstlane(mk2); mk3 = __builtin_amdgcn_readfirstlane(mk3);
        if (lane == 0) { selm[tk * 4 + 0] = mk0; selm[tk * 4 + 1] = mk1; selm[tk * 4 + 2] = mk2; selm[tk * 4 + 3] = mk3; }
        wu0 |= mk0; wu1 |= mk1; wu2 |= mk2; wu3 |= mk3;
    }
    if (lane == 0) { atomicOr((unsigned*)&BU[0], wu0); atomicOr((unsigned*)&BU[1], wu1); atomicOr((unsigned*)&BU[2], wu2); atomicOr((unsigned*)&BU[3], wu3); }
    asm volatile("s_waitcnt lgkmcnt(0)" ::: "memory");
    const unsigned ms0 = selm[tokl * 4 + 0], ms1 = selm[tokl * 4 + 1], ms2 = selm[tokl * 4 + 2], ms3 = selm[tokl * 4 + 3];
    __syncthreads();
    unsigned bu[4]; bu[0] = __builtin_amdgcn_readfirstlane(BU[0]); bu[1] = __builtin_amdgcn_readfirstlane(BU[1]); bu[2] = __builtin_amdgcn_readfirstlane(BU[2]); bu[3] = __builtin_amdgcn_readfirstlane(BU[3]);

    {
        f32x16 o[2];
#pragma unroll
        for (int d = 0; d < 2; ++d)
#pragma unroll
            for (int r = 0; r < 16; ++r) o[d][r] = 0.f;
        float m = NEGBIG, l = 0.f;
        int b = cur;
        for (;;) {
            if (b < 32) bu[0] &= ~(1u << b); else if (b < 64) bu[1] &= ~(1u << (b - 32)); else if (b < 96) bu[2] &= ~(1u << (b - 64)); else bu[3] &= ~(1u << (b - 96));
            __syncthreads();
            nsa_stage(lds, KS + (size_t)b * 64 * 64, VS + (size_t)b * 64 * 64, tid);
            __syncthreads();
            const unsigned wuw = b < 32 ? wu0 : (b < 64 ? wu1 : (b < 96 ? wu2 : wu3));
            if ((wuw >> (b & 31)) & 1u) {
                const unsigned msw = b < 32 ? ms0 : (b < 64 ? ms1 : (b < 96 ? ms2 : ms3));
                const bool selme = (msw >> (b & 31)) & 1u;
                f32x16 s0, s1;
#pragma unroll
                for (int r = 0; r < 16; ++r) { s0[r] = 0.f; s1[r] = 0.f; }
                qk_tile<4, NSA_PK>(Kt, qf, r32, hi, s0, s1);
                const int db = t - 64 * b - 4 * hi;
                const float c0 = selme ? -sl2 * (float)db : NEGBIG, c1 = selme ? -sl2 * (float)(db - 32) : NEGBIG;
                nsa_bias(s0, s1, c0, c1, sl2);
                if (b == cur) {
#pragma unroll
                    for (int r = 0; r < 16; ++r) { if (CR(r) > db) s0[r] = NEGBIG; if (CR(r) + 32 > db) s1[r] = NEGBIG; }
                }
                online_update<2>(s0, s1, m, l, o, wsf, r32, hi);
                pv_tile<2, NSA_PV>(Vt, s0, s1, o, lane);
            }
            if (bu[3]) b = 127 - __builtin_clz(bu[3]); else if (bu[2]) b = 95 - __builtin_clz(bu[2]); else if (bu[1]) b = 63 - __builtin_clz(bu[1]); else if (bu[0]) b = 31 - __builtin_clz(bu[0]); else break;
        }
        const float lt = l + __shfl_xor(l, 32);
        if (hi == 0) wsf[r32] = gs / lt;
        asm volatile("s_waitcnt lgkmcnt(0)" ::: "memory");
#pragma unroll
        for (int r = 0; r < 16; ++r) { const float a = wsf[crow(r, hi)]; yacc[0][r] += o[0][r] * a; yacc[1][r] += o[1][r] * a; }
        asm volatile("s_waitcnt lgkmcnt(0)" ::: "memory");
    }
    {
        f32x16 o[2];
#pragma unroll
        for (int d = 0; d < 2; ++d)
#pragma unroll
            for (int r = 0; r < 16; ++r) o[d][r] = 0.f;
        float m = NEGBIG, l = 0.f;
        const int ktlo = (t0 - 511) > 0 ? ((t0 - 511) >> 6) : 0;
        for (int kt = cur; kt >= ktlo; --kt) {
            __syncthreads();
            nsa_stage(lds, KW + (size_t)kt * 64 * 64, VW + (size_t)kt * 64 * 64, tid);
            __syncthreads();
            f32x16 s0, s1;
#pragma unroll
            for (int r = 0; r < 16; ++r) { s0[r] = 0.f; s1[r] = 0.f; }
            qk_tile<4, NSA_PK>(Kt, qf, r32, hi, s0, s1);
            const int db = t - 64 * kt - 4 * hi;
            nsa_bias(s0, s1, -sl2 * (float)db, -sl2 * (float)(db - 32), sl2);
            if (kt == cur) {
#pragma unroll
                for (int r = 0; r < 16; ++r) { if (CR(r) > db) s0[r] = NEGBIG; if (CR(r) + 32 > db) s1[r] = NEGBIG; }
            }
            if (t0 + 31 - 64 * kt >= 512) {
#pragma unroll
                for (int r = 0; r < 16; ++r) { if (db - CR(r) >= 512) s0[r] = NEGBIG; if (db - 32 - CR(r) >= 512) s1[r] = NEGBIG; }
            }
            online_update<2>(s0, s1, m, l, o, wsf, r32, hi);
            pv_tile<2, NSA_PV>(Vt, s0, s1, o, lane);
        }
        const float lt = l + __shfl_xor(l, 32);
        if (hi == 0) wsf[r32] = gw / lt;
        asm volatile("s_waitcnt lgkmcnt(0)" ::: "memory");
#pragma unroll
        for (int r = 0; r < 16; ++r) { const float a = wsf[crow(r, hi)]; yacc[0][r] += o[0][r] * a; yacc[1][r] += o[1][r] * a; }
        asm volatile("s_waitcnt lgkmcnt(0)" ::: "memory");
    }
    float ssq[4];
#pragma unroll
    for (int tk = 0; tk < 4; ++tk) ssq[tk] = 0.f;
#pragma unroll
    for (int r = 0; r < 16; ++r) {
        const int tk = r >> 2, hd = (r & 3) + 4 * hi;
#pragma unroll
        for (int d = 0; d < 2; ++d) { const float y = yacc[d][r]; ssq[tk] += y * y;
            Y[(size_t)(t0 + wave * 4 + tk) * DM + 1024 + (g * 8 + hd) * 64 + d * 32 + r32] = (bf16_t)(pk2(y, 0.f) & 0xffffu); }
    }
#pragma unroll
    for (int tk = 0; tk < 4; ++tk) { const float s = wave_sum(ssq[tk]); if (lane == 0) SSQN[(size_t)(t0 + wave * 4 + tk) * 2 + g] = s; }
    __syncthreads();
}


#define XB_TMO      128
#define XB_XCNT(j)  (256  + 64 * (j))
#define XB_XSUB(j)  (1280 + 64 * (j))
#define XB_XGEN(j)  (2304 + 64 * (j))
#define XB_TOP      3328
#define XB_TOPGEN   3392
#define XCD_BAR_WORDS 3456
#define XB_SPIN_CAP (1u << 18)
DI unsigned xb_ld(unsigned* p)              { return __hip_atomic_load(p, __ATOMIC_RELAXED, __HIP_MEMORY_SCOPE_AGENT); }
DI unsigned xb_add(unsigned* p, unsigned v) { return __hip_atomic_fetch_add(p, v, __ATOMIC_RELAXED, __HIP_MEMORY_SCOPE_AGENT); }
DI unsigned xb_xcc_id() { return (unsigned)__builtin_amdgcn_s_getreg((3 << 11) | 20) & 0xFu; }
#define XB_SPIN(cond, bar) do { unsigned _sp = 0; while (cond) { __builtin_amdgcn_s_sleep(1); \
    if ((++_sp & 255u) == 0u) { if (xb_ld(&(bar)[XB_TMO])) break; if (_sp > XB_SPIN_CAP) { atomicAdd(&(bar)[XB_TMO], 1u); break; } } } } while (0)
struct XcdBarrier { unsigned* bar; unsigned x; volatile LAS unsigned* st; };
DI XcdBarrier xcd_barrier_post(unsigned* bar, volatile LAS unsigned* st) {
    XcdBarrier b; b.bar = bar; b.x = xb_xcc_id(); b.st = st;
    if (threadIdx.x == 0) (void)xb_add(&bar[XB_XCNT(b.x)], 1u);
    return b;
}
DI void xcd_barrier_complete(unsigned* bar, unsigned x, unsigned& nloc, unsigned& nx) {
    const unsigned G = gridDim.x * gridDim.y * gridDim.z;
    unsigned sum, cnt, mine, sp = 0u;
    for (;;) {
        sum = 0u; cnt = 0u; mine = 0u;
#pragma unroll
        for (unsigned j = 0; j < 16; ++j) { const unsigned c = xb_ld(&bar[XB_XCNT(j)]); sum += c; cnt += (c > 0u) ? 1u : 0u; mine = (j == x) ? c : mine; }
        if (sum == G) break;
        __builtin_amdgcn_s_sleep(1);
        if ((++sp & 255u) == 0u) { if (xb_ld(&bar[XB_TMO])) break; if (sp > XB_SPIN_CAP) { atomicAdd(&bar[XB_TMO], 1u); break; } }
    }
    nloc = mine > 0u ? mine : 1u; nx = cnt > 0u ? cnt : 1u;
}
DI void xcd_barrier(const XcdBarrier& b) {
    asm volatile("s_waitcnt vmcnt(0)" ::: "memory");
    __syncthreads();
    if (threadIdx.x == 0) {
        unsigned* bar = b.bar;
        __builtin_amdgcn_s_waitcnt(0);
        unsigned nloc = b.st[0], nx = b.st[1];
        if (nloc == 0u) { xcd_barrier_complete(bar, b.x, nloc, nx); b.st[0] = nloc; b.st[1] = nx; }
        const unsigned old = xb_add(&bar[XB_XSUB(b.x)], 1u);
        const unsigned gen = old / nloc;
        if (old + 1u == (gen + 1u) * nloc) {
            __builtin_amdgcn_fence(__ATOMIC_RELEASE, "agent");
            asm volatile("s_waitcnt vmcnt(0)" ::: "memory");
            const unsigned og = xb_add(&bar[XB_TOP], 1u);
            const unsigned tg = og / nx;
            if (og + 1u == (tg + 1u) * nx) xb_add(&bar[XB_TOPGEN], 1u);
            else XB_SPIN(xb_ld(&bar[XB_TOPGEN]) == tg, bar);
            __builtin_amdgcn_fence(__ATOMIC_ACQUIRE, "agent");
            xb_add(&bar[XB_XGEN(b.x)], 1u);
            asm volatile("s_waitcnt vmcnt(0)" ::: "memory");
        } else {
            XB_SPIN(xb_ld(&bar[XB_XGEN(b.x)]) == gen, bar);
            __builtin_amdgcn_fence(__ATOMIC_ACQUIRE, "agent");
            asm volatile("s_waitcnt vmcnt(0)" ::: "memory");
        }
    }
    __syncthreads();
}

__global__ void __launch_bounds__(512, 2) mega_fwd(Params P) {
    extern __shared__ __attribute__((aligned(16))) unsigned char lds_raw[];
    LAS unsigned char* lds = (LAS unsigned char*)lds_raw;
    const int G = gridDim.x, tid = threadIdx.x, lane = tid & 63, wave = __builtin_amdgcn_readfirstlane(tid >> 6);
    unsigned char* ws = P.ws;
    if (tid < 8) ((LAS unsigned*)(lds + LDS_BYTES - 32))[tid] = 0u;
    __syncthreads();
    const XcdBarrier bar = xcd_barrier_post((unsigned*)(ws + WS_CTL) + 4096, (volatile LAS unsigned*)(lds + LDS_BYTES - 32));
    p0_prep(P, lds, G);
    xcd_barrier(bar);
    {
        pg8::Gemm g{(const bf16_t*)(ws + WS_XN), (const bf16_t*)(ws + WS_WIN), DM, DM, DM};
        pg8::Order S; S.init(T / 256, INWP / 256, G, blockIdx.x);
        EpiIn E{0, (bf16_t*)(ws + WS_CQ), (bf16_t*)(ws + WS_CKV), (bf16_t*)(ws + WS_QN), (bf16_t*)(ws + WS_KVC), (bf16_t*)(ws + WS_KVS), (bf16_t*)(ws + WS_KVW),
                (float*)(ws + WS_KR), (float*)(ws + WS_GATE), (float*)(ws + WS_SSQQ), (float*)(ws + WS_SSQKV)};
        pg8::gemm_phase(lds, g, S, E);
    }
    xcd_barrier(bar);
    {
        { pg8::Gemm g{(const bf16_t*)(ws + WS_CKV), (const bf16_t*)(ws + WS_WUKV), KVRANK, KVRANK, KVRANK};
          pg8::Order S; S.init(T / 256, 2048 / 256, G, blockIdx.x);
          EpiKV E{0, (bf16_t*)(ws + WS_KM), (bf16_t*)(ws + WS_VM), (const float*)(ws + WS_SSQKV)};
          pg8::gemm_phase(lds, g, S, E); }
        { pg8::Gemm g{(const bf16_t*)(ws + WS_CQ), (const bf16_t*)(ws + WS_WUQ), QRANK, QRANK, QRANK};
          pg8::Order S; S.init(T / 256, 1536 / 256, G, (blockIdx.x + 64) % G);
          EpiQ E{0, (bf16_t*)(ws + WS_QM), (const float*)(ws + WS_SSQQ), (const float*)(ws + WS_COS), (const float*)(ws + WS_SIN)};
          pg8::gemm_phase(lds, g, S, E); }
        { pg8::Gemm g{(const bf16_t*)(ws + WS_KVC), (const bf16_t*)(ws + WS_W1K), 1024, 2048, 2048};
          pg8::Order S; S.init(4, 1, G, (blockIdx.x + 8) % G);
          EpiHid E{0, (bf16_t*)(ws + WS_HIDK), (const float*)(ws + WS_B1)};
          pg8::gemm_phase(lds, g, S, E); }
        { pg8::Gemm g{(const bf16_t*)(ws + WS_KVC) + (size_t)2 * T * 64, (const bf16_t*)(ws + WS_W1V), 1024, 2048, 2048};
          pg8::Order S; S.init(4, 1, G, (blockIdx.x + 4) % G);
          EpiHid E{0, (bf16_t*)(ws + WS_HIDV), (const float*)(ws + WS_B1) + 256};
          pg8::gemm_phase(lds, g, S, E); }
        const float* KR = (const float*)(ws + WS_KR); const float* COS = (const float*)(ws + WS_COS); const float* SIN = (const float*)(ws + WS_SIN);
        bf16_t* KM = (bf16_t*)(ws + WS_KM);
        for (int i = blockIdx.x * 512 + tid; i < T * 32; i += G * 512) { const int t = i >> 5, j = i & 31;
            const float x1 = KR[(size_t)t * 64 + j], x2 = KR[(size_t)t * 64 + 32 + j], c = COS[i], s = SIN[i];
            const unsigned w = pk2(x1 * c - x2 * s, x2 * c + x1 * s);
#pragma unroll
            for (int h = 0; h < 8; ++h) *(unsigned*)(KM + (size_t)t * 1536 + h * 192 + 128 + 2 * j) = w; }
    }
    xcd_barrier(bar);
    {
        for (int i = blockIdx.x * 512 + tid; i < 2 * 1024 * 64; i += G * 512) { const int kv = i >> 16, row = (i >> 6) & 1023, col = i & 63;
            const bf16_t* hid = (const bf16_t*)(ws + (kv ? WS_HIDV : WS_HIDK)) + (size_t)row * 256; const float* w2 = kv ? P.cmp_w2_v : P.cmp_w2_k;
            float s = 0.f;
            if ((row & 511) != 511) { for (int k = 0; k < 256; ++k) s += bf2f(hid[k]) * w2[k * 64 + col]; }
            ((bf16_t*)(ws + (kv ? WS_VC : WS_KC)))[(size_t)row * 64 + col] = (bf16_t)(pk2(s, 0.f) & 0xffffu); }
    }
    xcd_barrier(bar);
    {
        unsigned* ctr = (unsigned*)(ws + WS_CTL);
        LAS int* ubox = (LAS int*)(lds + LDS_BYTES - 16);
        for (;;) {
            if (tid == 0) *ubox = (int)atomicAdd(ctr, 1u);
            __syncthreads();
            const int u = __builtin_amdgcn_readfirstlane(*ubox);
            __syncthreads();
            if (u >= 256) break;
            mla_unit(P, lds, u & 7, 31 - (u >> 3));
        }
        for (;;) {
            if (tid == 0) *ubox = (int)atomicAdd(ctr + 64, 1u);
            __syncthreads();
            const int v = __builtin_amdgcn_readfirstlane(*ubox);
            __syncthreads();
            if (v >= 512) break;
            nsa_unit(P, lds, 255 - (v >> 1), v & 1);
        }
    }
    xcd_barrier(bar);
    {
        pg8::Gemm g{(const bf16_t*)(ws + WS_XN), (const bf16_t*)(ws + WS_WO), DM, DM, 1024};
        pg8::Order2 S; S.init(T / 256, DM / 256, G, blockIdx.x, 1024);
        EpiO E{0, P.x, (const float*)(ws + WS_SSQM), (const float*)(ws + WS_SSQN), P.out, (float*)(ws + WS_SSQ2), (bf16_t*)(ws + WS_HB)};
        pg8::gemm_phase(lds, g, S, E);
    }
    xcd_barrier(bar);
    {
        pg8::Gemm g{(const bf16_t*)(ws + WS_HB), (const bf16_t*)(ws + WS_WUP), DM, DM, DM};
        pg8::Order S; S.init(T / 256, MLPH / 256, G, blockIdx.x);
        EpiUp E{0, (const float*)(ws + WS_SSQ2), (bf16_t*)(ws + WS_U)};
        pg8::gemm_phase(lds, g, S, E);
    }
    xcd_barrier(bar);
    {
        pg8::Gemm g{(const bf16_t*)(ws + WS_U), (const bf16_t*)(ws + WS_WDN), MLPH, MLPH, MLPH};
        pg8::Order S; S.init(T / 256, DM / 256, G, blockIdx.x);
        EpiDown E{0, P.out, (float*)(ws + WS_SSQ3)};
        pg8::gemm_phase(lds, g, S, E);
    }
    xcd_barrier(bar);
    {
        const float* SSQ3 = (const float*)(ws + WS_SSQ3);
        for (int row = blockIdx.x * 8 + wave; row < T; row += G * 8) {
            const float r = rsqrtf(sum32(SSQ3 + (size_t)row * 32) * (1.f / DM) + EPS);
            f32x4* o = (f32x4*)(P.out + (size_t)row * DM) + lane;
#pragma unroll
            for (int j = 0; j < 8; ++j) { const f32x4 w = *((const f32x4*)P.final_norm_w + lane + 64 * j); o[64 * j] = o[64 * j] * r * w; }
        }
    }
}

extern "C" void kernel_launch(void* const* d_in, const int* in_sizes, int n_in, void* d_out, int out_size, void* d_ws, size_t ws_size, hipStream_t stream) {
    static int grid = 0;
    if (grid == 0) {
        if (n_in != 21 || out_size != T * DM || ws_size < WS_END) { fprintf(stderr, "kernel_launch: unexpected shapes (n_in %d out %d ws %zu)\n", n_in, out_size, ws_size); grid = -1; return; }
        int dev = 0, cus = 0, per_cu = 0;
        hipGetDevice(&dev);
        hipDeviceGetAttribute(&cus, hipDeviceAttributeMultiprocessorCount, dev);
        hipFuncSetAttribute((const void*)mega_fwd, hipFuncAttributeMaxDynamicSharedMemorySize, LDS_BYTES);
        hipOccupancyMaxActiveBlocksPerMultiprocessor(&per_cu, (const void*)mega_fwd, 512, LDS_BYTES);
        if (per_cu < 1) { fprintf(stderr, "kernel_launch: occupancy query reports %d blocks per CU\n", per_cu); per_cu = 1; }
        (void)hipGetLastError();
        grid = cus;
    }
    if (grid < 0) return;
    hipMemsetAsync((char*)d_ws + WS_CTL, 0, 65536, stream);
    Params p{};
    p.x = (const float*)d_in[0]; p.positions = (const int*)d_in[1]; p.attn_norm_w = (const float*)d_in[2]; p.w_in = (const float*)d_in[3];
    p.mla_q_norm_w = (const float*)d_in[4]; p.mla_w_uq = (const float*)d_in[5]; p.mla_kv_norm_w = (const float*)d_in[6]; p.mla_w_ukv = (const float*)d_in[7];
    p.cmp_pos_k = (const float*)d_in[8]; p.cmp_pos_v = (const float*)d_in[9]; p.cmp_w1_k = (const float*)d_in[10]; p.cmp_w2_k = (const float*)d_in[11];
    p.cmp_w1_v = (const float*)d_in[12]; p.cmp_w2_v = (const float*)d_in[13]; p.mla_out_norm_w = (const float*)d_in[14]; p.nsa_out_norm_w = (const float*)d_in[15];
    p.w_o = (const float*)d_in[16]; p.mlp_norm_w = (const float*)d_in[17]; p.w_up = (const float*)d_in[18]; p.w_down = (const float*)d_in[19]; p.final_norm_w = (const float*)d_in[20];
    p.out = (float*)d_out; p.ws = (unsigned char*)d_ws;
    void* args[] = {&p};
    hipError_t e = hipLaunchCooperativeKernel((const void*)mega_fwd, dim3(grid), dim3(512), args, LDS_BYTES, stream);
    if (e != hipSuccess) fprintf(stderr, "cooperative launch failed: %s (grid %d)\n", hipGetErrorString(e), grid);
}
```

```cpp
#include <hip/hip_runtime.h>
#include <hip/hip_cooperative_groups.h>
#include <cstdio>
#include <cstdint>
namespace cg = cooperative_groups;

#define DI __device__ __forceinline__
#define LAS __attribute__((address_space(3)))
typedef unsigned short bf16_t;
typedef short bf16x8 __attribute__((ext_vector_type(8)));
typedef short s16x4 __attribute__((ext_vector_type(4)));
typedef float f32x4 __attribute__((ext_vector_type(4)));
typedef float f32x16 __attribute__((ext_vector_type(16)));
typedef float f32x2 __attribute__((ext_vector_type(2)));
typedef unsigned u32x4 __attribute__((ext_vector_type(4)));
typedef unsigned u32x2 __attribute__((ext_vector_type(2)));
typedef __bf16 bf16x2_t __attribute__((ext_vector_type(2)));

constexpr int T = 8192, DM = 2048, INW = 2672, INWP = 2816, MLPH = 8192;
constexpr int MH = 8, QRANK = 512, KVRANK = 256, DQK = 192, MDV = 128;
constexpr int NG = 2, NHG = 8, NDK = 64;
constexpr float EPS = 1e-6f, LOG2E = 1.4426950408889634f;
constexpr float QS_MLA = 0.07216878364870322f * LOG2E;
constexpr float QS_NSA = 0.125f * LOG2E;
constexpr float NEGBIG = -1e30f;

constexpr size_t MiB = 1u << 20;
constexpr size_t WS_WDN = 0, WS_WUP = 32 * MiB, WS_WO = 64 * MiB, WS_WIN = 72 * MiB, WS_WUQ = 83 * MiB, WS_WUKV = 84 * MiB + 512 * 1024,
                 WS_W1K = 85 * MiB + 512 * 1024, WS_W1V = 86 * MiB + 512 * 1024;
constexpr size_t WS_XN = 88 * MiB;
constexpr size_t WS_CQ = 120 * MiB, WS_CKV = 128 * MiB, WS_KR = 132 * MiB, WS_QN = 134 * MiB, WS_KVC = 150 * MiB, WS_KVS = 154 * MiB,
                 WS_KVW = 158 * MiB, WS_GATE = 162 * MiB;
constexpr size_t WS_QM = 164 * MiB, WS_KM = 188 * MiB, WS_VM = 212 * MiB, WS_HIDK = 228 * MiB, WS_HIDV = 228 * MiB + 512 * 1024,
                 WS_KC = 229 * MiB, WS_VC = 229 * MiB + 128 * 1024;
constexpr size_t WS_U = 88 * MiB, WS_HB = 216 * MiB;
constexpr size_t WS_PARTH = 230 * MiB;
constexpr size_t WS_CTL = 248 * MiB, WS_COS = 249 * MiB, WS_SIN = 250 * MiB, WS_B1 = 251 * MiB, WS_SSQ2 = 252 * MiB, WS_SSQ3 = 253 * MiB,
                 WS_SSQQ = 254 * MiB, WS_SSQKV = 254 * MiB + 256 * 1024, WS_SSQM = 254 * MiB + 512 * 1024, WS_SSQN = 254 * MiB + 768 * 1024;
constexpr size_t WS_END = 256 * MiB;

constexpr int LDS_BYTES = 147456;

DI unsigned pk2(float lo, float hi) { f32x2 v = {lo, hi}; bf16x2_t b = __builtin_convertvector(v, bf16x2_t); return __builtin_bit_cast(unsigned, b); }
DI float bf2f(bf16_t b) { return __uint_as_float(((unsigned)b) << 16); }
DI u32x2 pk4(f32x4 v) { u32x2 r; r.x = pk2(v[0], v[1]); r.y = pk2(v[2], v[3]); return r; }
DI float max_halves(float x) { const auto r = __builtin_amdgcn_permlane32_swap(__float_as_uint(x), __float_as_uint(x), false, false); float m; asm("v_max_f32 %0, %1, %2" : "=v"(m) : "v"(r[0]), "v"(r[1])); return m; }
DI float sum_halves(float x) { const auto r = __builtin_amdgcn_permlane32_swap(__float_as_uint(x), __float_as_uint(x), false, false); return __uint_as_float(r[0]) + __uint_as_float(r[1]); }
template <int CTRL> DI float dpp_f(float x) { return __int_as_float(__builtin_amdgcn_update_dpp(0, __float_as_int(x), CTRL, 0xf, 0xf, true)); }
DI float sum8(float x) { x += dpp_f<0xB1>(x); x += dpp_f<0x4E>(x); x += dpp_f<0x141>(x); return x; }
DI float wave_sum(float v) {
#pragma unroll
    for (int o = 1; o < 64; o <<= 1) v += __shfl_xor(v, o);
    return v;
}

namespace pg8 {
constexpr int BM = 256, BK = 64, HALF = 128, HTB = HALF * BK * 2, STAGE_BYTES = 8 * HTB;
DI int lds_byte(int r, int c) { const int st = (r >> 4) * 2 + (c >> 5), rr = r & 15, cc = c & 31, ob = rr * 64 + cc * 2; return st * 1024 + (ob ^ (((ob >> 9) & 1) << 5)); }
DI void stage_rc(int b, int& R, int& C) { const int st = b / 1024, sb = b % 1024, swz = sb ^ (((sb >> 9) & 1) << 5); R = (st >> 1) * 16 + swz / 64; C = (st & 1) * 32 + (swz % 64) / 2; }
DI int perm32(int rho) { const int n = rho >> 4, i = rho & 15; return 8 * (i >> 2) + 4 * n + (i & 3); }
struct Unit { int pm, pn, ko; };
struct Gemm { const bf16_t* A; const bf16_t* Bt; int lda, ldb, K; };

struct Order2 {
    int nM, ntot, G, c, kh;
    DI void init(int nM_, int nN_, int G_, int c_, int kh_) { nM = nM_; ntot = nM_ * nN_; G = G_; c = c_; kh = kh_; }
    DI bool next(int i, Unit& u) const { const int L = (i >> 1) * G + c; if (L >= ntot) return false; u.pm = L % nM; u.pn = L / nM; u.ko = (i & 1) * kh; return true; }
    DI void done(const Unit&) const {}
};
struct OrderCmp {
    int G, c;
    DI bool next(int i, Unit& u) const { const int L = i * G + c; if (L >= 32) return false; u.pm = L & 3; u.pn = 0; u.ko = (L >> 2) * 256; return true; }
    DI void done(const Unit&) const {}
};
struct OneUnit { Unit u0; DI bool next(int i, Unit& u) const { if (i) return false; u = u0; return true; } DI void done(const Unit&) const {} };
struct OrderP1 {
    int c; unsigned* cnt; unsigned* pcnt;
    DI bool next(int i, Unit& u) const { u.ko = 0; u.pm = c & 31;
        if (i == 0) { const int k = c >> 5; u.pn = k < 4 ? k : k + 3; return true; }
        if (i == 1 && c < 96) { u.pn = 4 + (c >> 5); return true; }
        return false; }
    DI void done(const Unit& u) const {
        if (u.pn >= 4 && u.pn <= 6) return;
        asm volatile("s_waitcnt vmcnt(0)" ::: "memory");
        __syncthreads();
        if (threadIdx.x == 0) { __builtin_amdgcn_fence(__ATOMIC_RELEASE, "agent"); asm volatile("s_waitcnt vmcnt(0)" ::: "memory");
            const int kind = u.pn <= 1 ? 0 : (u.pn == 2 ? 1 : (u.pn == 3 ? 2 : (u.pn <= 8 ? 3 : -1)));
            if (kind >= 0) __hip_atomic_fetch_add(pcnt + (kind * 32 + u.pm) * 4, 1u, __ATOMIC_RELAXED, __HIP_MEMORY_SCOPE_AGENT);
            __hip_atomic_fetch_add(cnt, 1u, __ATOMIC_RELAXED, __HIP_MEMORY_SCOPE_AGENT); }
    }
};
struct Order {
    int nM, ntot, G, c;
    DI void init(int nM_, int nN_, int G_, int c_) { nM = nM_; ntot = nM_ * nN_; G = G_; c = c_; }
    DI bool next(int i, Unit& u) const { const int L = i * G + c; if (L >= ntot) return false; u.pm = L % nM; u.pn = L / nM; u.ko = 0; return true; }
    DI void done(const Unit&) const {}
};

template <class Epi, class Sched>
DI void gemm_phase(LAS unsigned char* lds, const Gemm g, const Sched& S, const Epi& E) {
    int tid_ = threadIdx.x; asm volatile("" : "+v"(tid_));
    const int tid = tid_, wid = __builtin_amdgcn_readfirstlane(tid >> 6), lane = tid & 63, wr = wid >> 2, wc = wid & 3, fr = lane & 15, fq = lane >> 4;
    const int K = g.K, nt = K / BK;
    unsigned voffA[2], voffB[2];
#pragma unroll
    for (int i = 0; i < 2; ++i) { int R, C; stage_rc(tid * 16 + i * 8192, R, C);
        const int Rb = Epi::PERM ? ((R & ~31) + perm32(R & 31)) : R;
        voffA[i] = (unsigned)(R * g.lda + C) * 2u; voffB[i] = (unsigned)(Rb * g.ldb + C) * 2u; }
    const size_t kstep = (size_t)(BK * 2);
    const size_t hstepA = (size_t)HALF * g.lda * 2, hstepB = (size_t)HALF * g.ldb * 2;
    const size_t tstepA = 2 * hstepA, tstepB = 2 * hstepB;
    const unsigned ldsw = (unsigned)wid * 1024u;
    const int aoff = lds_byte(wr * 64 + fr, fq * 8), boff = lds_byte(wc * 32 + fr, fq * 8);
#define PG8_SA(b, h) (((b) * 2 + (h)) * HTB)
#define PG8_SB(b, h) ((4 + (b) * 2 + (h)) * HTB)
#define PG8_STAGE(bufoff, gbase, voff) do { _Pragma("unroll") for (int _i = 0; _i < 2; ++_i) \
        __builtin_amdgcn_global_load_lds((const unsigned*)((const char*)(gbase) + (voff)[_i]), (LAS unsigned*)(lds + (bufoff) + ldsw + _i * 8192), 16, 0, 0); } while (0)
#define PG8_LDA(dst, b, h) do { _Pragma("unroll") for (int m = 0; m < 4; ++m) _Pragma("unroll") for (int k = 0; k < 2; ++k) dst[m][k] = *(const LAS bf16x8*)(lds + PG8_SA(b, h) + aoff + m * 2048 + k * 1024); } while (0)
#define PG8_LDB(dst, b, h) do { _Pragma("unroll") for (int n = 0; n < 2; ++n) _Pragma("unroll") for (int k = 0; k < 2; ++k) dst[n][k] = *(const LAS bf16x8*)(lds + PG8_SB(b, h) + boff + n * 2048 + k * 1024); } while (0)
#define PG8_MMA(ai, bj, At, Bt) do { __builtin_amdgcn_s_setprio(1); _Pragma("unroll") for (int m = 0; m < 4; ++m) _Pragma("unroll") for (int n = 0; n < 2; ++n) _Pragma("unroll") for (int k = 0; k < 2; ++k) \
        acc[ai][bj][m][n] = __builtin_amdgcn_mfma_f32_16x16x32_bf16(Bt[n][k], At[m][k], acc[ai][bj][m][n], 0, 0, 0); __builtin_amdgcn_s_setprio(0); } while (0)
#define PG8_WAIT_V(n) asm volatile("s_waitcnt vmcnt(" #n ")" ::: "memory")
#define PG8_WAIT_L(n) asm volatile("s_waitcnt lgkmcnt(" #n ")" ::: "memory")
#define PG8_BAR __builtin_amdgcn_s_barrier()
#define PG8_SCHED __builtin_amdgcn_sched_barrier(0)
    Unit cur, nxt; int ui = 0;
    if (!S.next(0, cur)) return;
    f32x4 acc[2][2][4][2];
#pragma unroll
    for (int a = 0; a < 2; ++a)
#pragma unroll
        for (int b = 0; b < 2; ++b)
#pragma unroll
            for (int m = 0; m < 4; ++m)
#pragma unroll
                for (int n = 0; n < 2; ++n) acc[a][b][m][n] = (f32x4){0.f, 0.f, 0.f, 0.f};
    bf16x8 At[4][2], B0[2][2], B1[2][2];
    const char* cA = (const char*)g.A + (size_t)cur.pm * tstepA + (size_t)cur.ko * 2; const char* cB = (const char*)g.Bt + (size_t)cur.pn * tstepB + (size_t)cur.ko * 2;
    PG8_STAGE(PG8_SB(0, 0), cB, voffB); PG8_STAGE(PG8_SB(0, 1), cB + hstepB, voffB); PG8_STAGE(PG8_SA(0, 0), cA, voffA); PG8_STAGE(PG8_SA(0, 1), cA + hstepA, voffA);
    if (wr == 1) PG8_BAR;
    PG8_WAIT_V(2); PG8_BAR;
    PG8_STAGE(PG8_SB(1, 0), cB + kstep, voffB); PG8_STAGE(PG8_SA(1, 0), cA + kstep, voffA); PG8_STAGE(PG8_SB(1, 1), cB + hstepB + kstep, voffB);
    PG8_WAIT_V(6); PG8_BAR;
    for (;;) {
        const bool has_next = S.next(ui + 1, nxt);
        const char* nA = has_next ? (const char*)g.A + (size_t)nxt.pm * tstepA + (size_t)nxt.ko * 2 : cA; const char* nB = has_next ? (const char*)g.Bt + (size_t)nxt.pn * tstepB + (size_t)nxt.ko * 2 : cB;
#pragma clang loop unroll(disable)
        for (int t = 0; t < nt; t += 2) {
            const bool last = (t == nt - 2);
            const char* a1 = cA + (size_t)(t + 1) * kstep;
            const char* a2 = last ? nA : cA + (size_t)(t + 2) * kstep; const char* b2 = last ? nB : cB + (size_t)(t + 2) * kstep;
            const char* a3 = a2 + kstep; const char* b3 = b2 + kstep;
            PG8_LDB(B0, 0, 0); PG8_LDB(B1, 0, 1); PG8_SCHED; PG8_LDA(At, 0, 0); PG8_STAGE(PG8_SA(1, 1), a1 + hstepA, voffA);
            PG8_WAIT_V(8); PG8_WAIT_L(0); PG8_BAR; PG8_MMA(0, 0, At, B0); PG8_MMA(0, 1, At, B1); PG8_BAR; PG8_SCHED;
            PG8_LDA(At, 0, 1); PG8_STAGE(PG8_SB(0, 0), b2, voffB); PG8_STAGE(PG8_SB(0, 1), b2 + hstepB, voffB); PG8_STAGE(PG8_SA(0, 0), a2, voffA);
            PG8_WAIT_V(8); PG8_WAIT_L(0); PG8_BAR; PG8_MMA(1, 0, At, B0); PG8_MMA(1, 1, At, B1); PG8_BAR; PG8_SCHED;
            PG8_LDB(B0, 1, 0); PG8_LDB(B1, 1, 1); PG8_SCHED; PG8_LDA(At, 1, 0); PG8_STAGE(PG8_SA(0, 1), a2 + hstepA, voffA);
            PG8_WAIT_V(8); PG8_WAIT_L(0); PG8_BAR; PG8_MMA(0, 0, At, B0); PG8_MMA(0, 1, At, B1); PG8_BAR; PG8_SCHED;
            PG8_LDA(At, 1, 1); PG8_STAGE(PG8_SB(1, 0), b3, voffB); PG8_STAGE(PG8_SB(1, 1), b3 + hstepB, voffB); PG8_STAGE(PG8_SA(1, 0), a3, voffA);
            PG8_WAIT_V(8); PG8_WAIT_L(0); PG8_BAR; PG8_MMA(1, 0, At, B0); PG8_MMA(1, 1, At, B1); PG8_BAR; PG8_SCHED;
        }
        if (wr == 0) PG8_BAR;
        { Unit ue = cur; asm volatile("" : "+s"(ue.pm), "+s"(ue.pn), "+s"(ue.ko));
          E(acc, ue, wr, wc, fr, fq); }
        S.done(cur);
        if (!has_next) break;
#pragma unroll
        for (int a = 0; a < 2; ++a)
#pragma unroll
            for (int b = 0; b < 2; ++b)
#pragma unroll
                for (int m = 0; m < 4; ++m)
#pragma unroll
                    for (int n = 0; n < 2; ++n) acc[a][b][m][n] = (f32x4){0.f, 0.f, 0.f, 0.f};
        cur = nxt; cA = nA; cB = nB; ++ui;
        if (wr == 1) PG8_BAR;
    }
    PG8_WAIT_V(0);
    PG8_BAR;
#undef PG8_SA
#undef PG8_SB
#undef PG8_STAGE
#undef PG8_LDA
#undef PG8_LDB
#undef PG8_MMA
#undef PG8_WAIT_V
#undef PG8_WAIT_L
#undef PG8_BAR
#undef PG8_SCHED
}
}
using pg8::Unit;

#define EPI_ROWS(ri, row) _Pragma("unroll") for (int ai = 0; ai < 2; ++ai) _Pragma("unroll") for (int m = 0; m < 4; ++m) { const int ri = ai * 4 + m; const int row = u.pm * 256 + ai * 128 + wr * 64 + m * 16 + fr;
#define EPI_COLS(col, v) _Pragma("unroll") for (int bj = 0; bj < 2; ++bj) _Pragma("unroll") for (int n = 0; n < 2; ++n) { const int col = u.pn * 256 + bj * 128 + wc * 32 + n * 16 + fq * 4; f32x4& v = acc[ai][bj][m][n];
#define EPI_END }
typedef f32x4 Acc[2][2][4][2];

DI float dot4(f32x4 v) { return (v[0] * v[0] + v[1] * v[1]) + (v[2] * v[2] + v[3] * v[3]); }

#define EPI_COLS8(col, v0, v1) _Pragma("unroll") for (int bj = 0; bj < 2; ++bj) { const int col = u.pn * 256 + bj * 128 + wc * 32 + fq * 8; f32x4& v0 = acc[ai][bj][m][0]; f32x4& v1 = acc[ai][bj][m][1];
DI u32x4 pk8(f32x4 a, f32x4 b) { u32x4 w; w.x = pk2(a[0], a[1]); w.y = pk2(a[2], a[3]); w.z = pk2(b[0], b[1]); w.w = pk2(b[2], b[3]); return w; }
DI float sigm(float v) { return 1.f / (1.f + __expf(-v)); }
struct EpiIn {
    static constexpr bool HAS_MID = false, PERM = true; int tmid;
    bf16_t *CQ, *CKV, *QN, *KVC, *KVS, *KVW; float *KR, *GATE, *SSQQ, *SSQKV;
    DI void mid(Acc&, const Unit&, int, int, int, int) const {}
    DI void operator()(Acc& acc, const Unit& u, int wr, int wc, int fr, int fq) const {
        EPI_ROWS(ri, row)
            EPI_COLS8(col, v0, v1)
                if (col < 512) { *(u32x4*)(CQ + (size_t)row * 512 + col) = pk8(v0, v1); }
                else if (col < 768) { *(u32x4*)(CKV + (size_t)row * 256 + (col - 512)) = pk8(v0, v1); }
                else if (col < 832) { float* kr = KR + (size_t)row * 64 + (col - 768); *(f32x4*)kr = v0; *(f32x4*)(kr + 4) = v1; }
                else if (col < 1856) { *(u32x4*)(QN + (size_t)row * 1024 + (col - 832)) = pk8(v0 * QS_NSA, v1 * QS_NSA); }
                else if (col < 2624) { const int cc = col - 1856, kind = cc >> 8, c2 = cc & 255, g = c2 >> 7, d = c2 & 127, isv = d >> 6;
                    *(u32x4*)(KVC + (size_t)kind * (4 * MiB / 2) + ((size_t)(isv * 2 + g) * T + row) * 64 + (d & 63)) = pk8(v0, v1); }
                else if (col < 2672) { float* gp = GATE + (size_t)row * 48 + (col - 2624);
                    *(f32x4*)gp = (f32x4){sigm(v0[0]), sigm(v0[1]), sigm(v0[2]), sigm(v0[3])}; *(f32x4*)(gp + 4) = (f32x4){sigm(v1[0]), sigm(v1[1]), sigm(v1[2]), sigm(v1[3])}; }
            EPI_END
        EPI_END
        if (u.pn <= 2) {
            EPI_ROWS(ri, row)
                float s = (dot4(acc[ai][0][m][0]) + dot4(acc[ai][0][m][1])) + (dot4(acc[ai][1][m][0]) + dot4(acc[ai][1][m][1]));
                s += __shfl_xor(s, 16); s += __shfl_xor(s, 32);
                if (fq == 0) { if (u.pn < 2) SSQQ[(size_t)row * 8 + u.pn * 4 + wc] = s; else SSQKV[(size_t)row * 4 + wc] = s; }
            EPI_END
        }
    }
};
struct EpiQ {
    static constexpr bool HAS_MID = false, PERM = true; int tmid;
    bf16_t* QM; const float *SSQQ, *COS, *SIN;
    DI void mid(Acc&, const Unit&, int, int, int, int) const {}
    DI void operator()(Acc& acc, const Unit& u, int wr, int wc, int fr, int fq) const {
        EPI_ROWS(ri, row)
            const f32x4 a = *(const f32x4*)(SSQQ + (size_t)row * 8), b = *(const f32x4*)(SSQQ + (size_t)row * 8 + 4);
            const float r = rsqrtf(((a[0] + a[1]) + (a[2] + a[3]) + (b[0] + b[1]) + (b[2] + b[3])) * (1.f / 512.f) + EPS);
            EPI_COLS8(col, v0, v1)
                const int h = col / 192, p = col - h * 192;
                f32x4 x0 = v0 * r, x1 = v1 * r;
                if (p >= 128) { const int i = (p - 128) >> 1;
                    const f32x4 c = *(const f32x4*)(COS + (size_t)row * 32 + i), sn = *(const f32x4*)(SIN + (size_t)row * 32 + i);
                    f32x4 o0, o1;
                    o0[0] = x0[0] * c[0] - x0[1] * sn[0]; o0[1] = x0[1] * c[0] + x0[0] * sn[0]; o0[2] = x0[2] * c[1] - x0[3] * sn[1]; o0[3] = x0[3] * c[1] + x0[2] * sn[1];
                    o1[0] = x1[0] * c[2] - x1[1] * sn[2]; o1[1] = x1[1] * c[2] + x1[0] * sn[2]; o1[2] = x1[2] * c[3] - x1[3] * sn[3]; o1[3] = x1[3] * c[3] + x1[2] * sn[3];
                    x0 = o0; x1 = o1; }
                *(u32x4*)(QM + (size_t)row * 1536 + col) = pk8(x0 * QS_MLA, x1 * QS_MLA);
            EPI_END
        EPI_END
    }
};
struct EpiKV {
    static constexpr bool HAS_MID = false, PERM = true; int tmid;
    bf16_t *KM, *VM; const float* SSQKV;
    DI void mid(Acc&, const Unit&, int, int, int, int) const {}
    DI void operator()(Acc& acc, const Unit& u, int wr, int wc, int fr, int fq) const {
        EPI_ROWS(ri, row)
            const f32x4 a = *(const f32x4*)(SSQKV + (size_t)row * 4);
            const float r = rsqrtf(((a[0] + a[1]) + (a[2] + a[3])) * (1.f / 256.f) + EPS);
            EPI_COLS8(col, v0, v1)
                const int h = col >> 8, d = col & 255;
                const u32x4 w = pk8(v0 * r, v1 * r);
                if (d < 128) *(u32x4*)(KM + (size_t)row * 1536 + h * 192 + d) = w;
                else *(u32x4*)(VM + (size_t)row * 1024 + h * 128 + (d - 128)) = w;
            EPI_END
        EPI_END
    }
};
DI float gelu_tanh(float x) { const float z = 0.7978845608028654f * (x + 0.044715f * x * x * x); const float e = __expf(2.f * z); const float th = 1.f - 2.f / (e + 1.f); return 0.5f * x * (1.f + th); }
struct EpiPart {
    static constexpr bool HAS_MID = false, PERM = true; int tmid;
    float* PART;
    DI void mid(Acc&, const Unit&, int, int, int, int) const {}
    DI void operator()(Acc& acc, const Unit& u, int wr, int wc, int fr, int fq) const {
        float* base = PART + (size_t)(u.ko >> 8) * 1024 * 256;
        EPI_ROWS(ri, row)
            EPI_COLS8(col, v0, v1) float* pp = base + (size_t)row * 256 + col; *(f32x4*)pp = v0; *(f32x4*)(pp + 4) = v1; EPI_END
        EPI_END
    }
};
struct EpiO {
    static constexpr bool HAS_MID = false, PERM = true; int tmid;
    const float* X; float *H, *SSQ2; bf16_t* HB; const float* SSQN;
    DI void mid(Acc&, const Unit&, int, int, int, int) const {}
    DI void operator()(Acc& acc, const Unit& u, int wr, int wc, int fr, int fq) const {
        EPI_ROWS(ri, row)
            float ss = 0.f;
            const f32x2 cn = *(const f32x2*)(SSQN + (size_t)row * 2);
            const float rn = rsqrtf((cn[0] + cn[1]) * (1.f / 1024.f) + EPS);
            EPI_COLS8(col, v0, v1)
                const float* xp = X + (size_t)row * DM + col;
                const f32x4 h0 = *(const f32x4*)xp + v0 * rn, h1 = *(const f32x4*)(xp + 4) + v1 * rn;
                *(u32x4*)(HB + (size_t)row * DM + col) = pk8(h0, h1); ss += dot4(h0) + dot4(h1);
            EPI_END
            ss += __shfl_xor(ss, 16); ss += __shfl_xor(ss, 32);
            if (fq == 0) SSQ2[(size_t)row * 32 + u.pn * 4 + wc] = ss;
            asm volatile("" ::: "memory");
        EPI_END
    }
};
DI float sum32(const float* p) { float s = 0.f;
#pragma unroll
    for (int j = 0; j < 8; ++j) { const f32x4 a = *(const f32x4*)(p + 4 * j); s += (a[0] + a[1]) + (a[2] + a[3]); }
    return s; }
struct EpiUp {
    static constexpr bool HAS_MID = false, PERM = true; int tmid;
    const LAS float* R2T; bf16_t* U;
    DI void mid(Acc&, const Unit&, int, int, int, int) const {}
    DI void operator()(Acc& acc, const Unit& u, int wr, int wc, int fr, int fq) const {
        EPI_ROWS(ri, row)
            const float r = R2T[row & 255];
#pragma unroll
            for (int bj = 0; bj < 2; ++bj) {
                const int col = u.pn * 256 + bj * 128 + wc * 32 + 8 * fq;
                f32x4 o0, o1;
#pragma unroll
                for (int j = 0; j < 4; ++j) { const float a = fmaxf(acc[ai][bj][m][0][j] * r, 0.f); o0[j] = a * a; const float b = fmaxf(acc[ai][bj][m][1][j] * r, 0.f); o1[j] = b * b; }
                u32x4 w; w.x = pk2(o0[0], o0[1]); w.y = pk2(o0[2], o0[3]); w.z = pk2(o1[0], o1[1]); w.w = pk2(o1[2], o1[3]);
                *(u32x4*)(U + (size_t)row * MLPH + col) = w;
            }
        EPI_END
    }
};
struct EpiDown {
    static constexpr bool HAS_MID = false, PERM = true; int tmid;
    const bf16_t* HB; float *H, *SSQ3;
    DI void mid(Acc&, const Unit&, int, int, int, int) const {}
    DI void operator()(Acc& acc, const Unit& u, int wr, int wc, int fr, int fq) const {
        EPI_ROWS(ri, row)
            float ss = 0.f;
            EPI_COLS8(col, v0, v1)
                const u32x4 hb = *(const u32x4*)(HB + (size_t)row * DM + col);
                const f32x4 o0 = (f32x4){__uint_as_float(hb.x << 16), __uint_as_float(hb.x & 0xffff0000u), __uint_as_float(hb.y << 16), __uint_as_float(hb.y & 0xffff0000u)} + v0;
                const f32x4 o1 = (f32x4){__uint_as_float(hb.z << 16), __uint_as_float(hb.z & 0xffff0000u), __uint_as_float(hb.w << 16), __uint_as_float(hb.w & 0xffff0000u)} + v1;
                float* hp = H + (size_t)row * DM + col; *(f32x4*)hp = o0; *(f32x4*)(hp + 4) = o1; ss += dot4(o0) + dot4(o1);
            EPI_END
            ss += __shfl_xor(ss, 16); ss += __shfl_xor(ss, 32);
            if (fq == 0) SSQ3[(size_t)row * 32 + u.pn * 4 + wc] = ss;
        EPI_END
    }
};
struct EpiDownNorm {
    static constexpr bool HAS_MID = false, PERM = true; int tmid;
    const bf16_t* HB; float* OUT; float* XS; unsigned* CNT; const float* W; LAS float* L;
    DI void mid(Acc&, const Unit&, int, int, int, int) const {}
    DI void operator()(Acc& acc, const Unit& u, int wr, int wc, int fr, int fq) const {
        LAS float* PT = L;
        LAS float* RT = L + 1024;
        EPI_ROWS(ri, row)
            float ss = 0.f;
            EPI_COLS8(col, v0, v1)
                const u32x4 hb = *(const u32x4*)(HB + (size_t)row * DM + col);
                v0[0] += __uint_as_float(hb.x << 16); v0[1] += __uint_as_float(hb.x & 0xffff0000u); v0[2] += __uint_as_float(hb.y << 16); v0[3] += __uint_as_float(hb.y & 0xffff0000u);
                v1[0] += __uint_as_float(hb.z << 16); v1[1] += __uint_as_float(hb.z & 0xffff0000u); v1[2] += __uint_as_float(hb.w << 16); v1[3] += __uint_as_float(hb.w & 0xffff0000u); ss += dot4(v0) + dot4(v1);
            EPI_END
            ss += __shfl_xor(ss, 16); ss += __shfl_xor(ss, 32);
            if (fq == 0) PT[(row & 255) * 4 + wc] = ss;
            asm volatile("" ::: "memory");
        EPI_END
        __syncthreads();
        const int tid = threadIdx.x;
        if (tid < 256) { const f32x4 p = *(const LAS f32x4*)(PT + tid * 4);
            __hip_atomic_store((unsigned*)(XS + (size_t)(u.pm * 256 + tid) * 8 + u.pn), __float_as_uint((p[0] + p[1]) + (p[2] + p[3])), __ATOMIC_RELAXED, __HIP_MEMORY_SCOPE_AGENT); }
        asm volatile("s_waitcnt vmcnt(0)" ::: "memory");
        __syncthreads();
        if (tid == 0) {
            unsigned* c = CNT + 64 * u.pm;
            __hip_atomic_fetch_add(c, 1u, __ATOMIC_RELAXED, __HIP_MEMORY_SCOPE_AGENT);
            unsigned sp = 0;
            while (__hip_atomic_load(c, __ATOMIC_RELAXED, __HIP_MEMORY_SCOPE_AGENT) < 8u) { __builtin_amdgcn_s_sleep(2); if (++sp > (1u << 22)) break; }
            __builtin_amdgcn_fence(__ATOMIC_ACQUIRE, "agent");
            asm volatile("s_waitcnt vmcnt(0)" ::: "memory");
        }
        __syncthreads();
        if (tid < 256) { const float* xs = XS + (size_t)(u.pm * 256 + tid) * 8; float tot = 0.f;
#pragma unroll
            for (int j = 0; j < 8; ++j) tot += __uint_as_float(__hip_atomic_load((const unsigned*)(xs + j), __ATOMIC_RELAXED, __HIP_MEMORY_SCOPE_AGENT));
            RT[tid] = rsqrtf(tot * (1.f / DM) + EPS); }
        __syncthreads();
        EPI_ROWS(ri, row)
            const float r = RT[row & 255];
            EPI_COLS8(col, v0, v1)
                const f32x4 w0 = *(const f32x4*)(W + col), w1 = *(const f32x4*)(W + col + 4);
                float* op = OUT + (size_t)row * DM + col; *(f32x4*)op = v0 * r * w0; *(f32x4*)(op + 4) = v1 * r * w1;
            EPI_END
        EPI_END
    }
};

struct Params {
    const float *x, *attn_norm_w, *w_in, *mla_q_norm_w, *mla_w_uq, *mla_kv_norm_w, *mla_w_ukv, *cmp_pos_k, *cmp_pos_v, *cmp_w1_k, *cmp_w2_k,
        *cmp_w1_v, *cmp_w2_v, *mla_out_norm_w, *nsa_out_norm_w, *w_o, *mlp_norm_w, *w_up, *w_down, *final_norm_w;
    const int* positions;
    float* out; unsigned char* ws;
};

template <class RowMap>
DI void transpose_item(const float* W, int K, int N, bf16_t* WT, const float* kscale, const float* kscale2, int ksplit, LAS float* scr, int item, int lane, RowMap rowmap) {
    const int nblk = (N + 31) / 32, kb = item / nblk, nb = item % nblk, k0 = 64 * kb, n0 = 32 * nb;
    const int nn = n0 + (lane & 31);
    float vals[32];
#pragma unroll
    for (int i = 0; i < 32; ++i) { const int k = k0 + 2 * i + (lane >> 5); vals[i] = nn < N ? __builtin_nontemporal_load(W + (size_t)k * N + nn) : 0.f; }
#pragma unroll
    for (int i = 0; i < 32; ++i) { const int kk = 2 * i + (lane >> 5); const int k = k0 + kk;
        float v = vals[i];
        if (kscale) v *= (k < ksplit ? kscale[k] : kscale2[k - ksplit]);
        scr[kk * 33 + (lane & 31)] = v; }
    asm volatile("s_waitcnt lgkmcnt(0)" ::: "memory");
    const int c = lane & 7;
#pragma unroll
    for (int j = 0; j < 4; ++j) { const int n = (lane >> 3) + 8 * j; const LAS float* s = scr + (8 * c) * 33 + n;
        u32x4 o; o.x = pk2(s[0 * 33], s[1 * 33]); o.y = pk2(s[2 * 33], s[3 * 33]); o.z = pk2(s[4 * 33], s[5 * 33]); o.w = pk2(s[6 * 33], s[7 * 33]);
        if (n0 + n < N) *(u32x4*)(WT + (size_t)rowmap(n0 + n) * K + k0 + 8 * c) = o; }
    asm volatile("s_waitcnt lgkmcnt(0)" ::: "memory");
}
struct RowId { DI int operator()(int n) const { return n; } };
struct RowUq { DI int operator()(int n) const { const int h = n / 192, d = n - h * 192; if (d < 128) return n; const int i = d - 128; return h * 192 + 128 + (i < 32 ? 2 * i : 2 * (i - 32) + 1); } };

DI void sincos_acc(float a, float& sn, float& cs) {
    const double ad = (double)a;
    const double q = __builtin_rint(ad * 0.6366197723675814);
    const double r = (ad - q * 1.5707963267948966) - q * 6.123233995736766e-17;
    const double r2 = r * r;
    const double sp = r * (1.0 + r2 * (-1.0 / 6 + r2 * (1.0 / 120 + r2 * (-1.0 / 5040 + r2 * (1.0 / 362880 + r2 * (-1.0 / 39916800))))));
    const double cp = 1.0 + r2 * (-0.5 + r2 * (1.0 / 24 + r2 * (-1.0 / 720 + r2 * (1.0 / 40320 + r2 * (-1.0 / 3628800 + r2 * (1.0 / 479001600))))));
    const int qi = ((int)q) & 3;
    const double s = (qi == 0) ? sp : (qi == 1) ? cp : (qi == 2) ? -sp : -cp;
    const double c = (qi == 0) ? cp : (qi == 1) ? -sp : (qi == 2) ? -cp : sp;
    sn = (float)s; cs = (float)c;
}

DI void p0_prep(const Params& P, LAS unsigned char* lds, int G) {
    const int tid = threadIdx.x, lane = tid & 63, wave = __builtin_amdgcn_readfirstlane(tid >> 6);
    LAS float* scr = (LAS float*)(lds + wave * 16384);
    const int gw = blockIdx.x * 8 + wave, NGW = G * 8;
    unsigned char* ws = P.ws;
    bf16_t* Win_t = (bf16_t*)(ws + WS_WIN); bf16_t* Wuq_t = (bf16_t*)(ws + WS_WUQ); bf16_t* Wukv_t = (bf16_t*)(ws + WS_WUKV);
    bf16_t* W1k_t = (bf16_t*)(ws + WS_W1K); bf16_t* W1v_t = (bf16_t*)(ws + WS_W1V); bf16_t* Wo_t = (bf16_t*)(ws + WS_WO);
    bf16_t* Wup_t = (bf16_t*)(ws + WS_WUP); bf16_t* Wdn_t = (bf16_t*)(ws + WS_WDN);
    constexpr int I_IN = (DM / 64) * ((INW + 31) / 32), I_UQ = (QRANK / 64) * (1536 / 32), I_UKV = (KVRANK / 64) * (2048 / 32), I_W1 = (2048 / 64) * (256 / 32),
                  I_O = (DM / 64) * (DM / 32), I_UP = (DM / 64) * (MLPH / 32), I_DN = (MLPH / 64) * (DM / 32);
    constexpr int NITEMS = I_IN + I_UQ + I_UKV + 2 * I_W1;
    for (int it = gw; it < NITEMS; it += NGW) {
        int r = it;
        if (r < I_IN) { transpose_item(P.w_in, DM, INW, Win_t, nullptr, nullptr, 0, scr, r, lane, RowId()); continue; } r -= I_IN;
        if (r < I_UQ) { transpose_item(P.mla_w_uq, QRANK, 1536, Wuq_t, P.mla_q_norm_w, P.mla_q_norm_w, QRANK, scr, r, lane, RowUq()); continue; } r -= I_UQ;
        if (r < I_UKV) { transpose_item(P.mla_w_ukv, KVRANK, 2048, Wukv_t, P.mla_kv_norm_w, P.mla_kv_norm_w, KVRANK, scr, r, lane, RowId()); continue; } r -= I_UKV;
        if (r < I_W1) { transpose_item(P.cmp_w1_k, 2048, 256, W1k_t, nullptr, nullptr, 0, scr, r, lane, RowId()); continue; } r -= I_W1;
        transpose_item(P.cmp_w1_v, 2048, 256, W1v_t, nullptr, nullptr, 0, scr, r, lane, RowId());
    }
    bf16_t* XN = (bf16_t*)(ws + WS_XN);
    for (int row = gw; row < T; row += 2 * NGW) {
        const int row2 = row + NGW; const bool has2 = row2 < T;
        const f32x4* xa = (const f32x4*)(P.x + (size_t)row * DM) + 2 * lane; const f32x4* xb = (const f32x4*)(P.x + (size_t)(has2 ? row2 : row) * DM) + 2 * lane;
        f32x4 va[8], vb[8]; float sa = 0.f, sb = 0.f;
#pragma unroll
        for (int j = 0; j < 4; ++j) { va[2 * j] = __builtin_nontemporal_load(xa + 128 * j); va[2 * j + 1] = __builtin_nontemporal_load(xa + 128 * j + 1);
                                      vb[2 * j] = __builtin_nontemporal_load(xb + 128 * j); vb[2 * j + 1] = __builtin_nontemporal_load(xb + 128 * j + 1); }
#pragma unroll
        for (int j = 0; j < 8; ++j) { sa += dot4(va[j]); sb += dot4(vb[j]); }
        const float ra = rsqrtf(wave_sum(sa) * (1.f / DM) + EPS), rb = rsqrtf(wave_sum(sb) * (1.f / DM) + EPS);
#pragma unroll
        for (int j = 0; j < 4; ++j) { const f32x4 w0 = *((const f32x4*)P.attn_norm_w + 2 * lane + 128 * j), w1 = *((const f32x4*)P.attn_norm_w + 2 * lane + 128 * j + 1);
            const u32x2 a0 = pk4(va[2 * j] * ra * w0), a1 = pk4(va[2 * j + 1] * ra * w1);
            *(u32x4*)(XN + (size_t)row * DM + (2 * lane + 128 * j) * 4) = (u32x4){a0.x, a0.y, a1.x, a1.y};
            if (has2) { const u32x2 b0 = pk4(vb[2 * j] * rb * w0), b1 = pk4(vb[2 * j + 1] * rb * w1);
                *(u32x4*)(XN + (size_t)row2 * DM + (2 * lane + 128 * j) * 4) = (u32x4){b0.x, b0.y, b1.x, b1.y}; } }
    }
    const int gt = blockIdx.x * 512 + tid, NGT = G * 512;
    for (int i = gt; i < (INWP - INW) * DM / 8; i += NGT) *(u32x4*)(Win_t + (size_t)INW * DM + (size_t)i * 8) = (u32x4){0u, 0u, 0u, 0u};
    float* COS = (float*)(ws + WS_COS); float* SIN = (float*)(ws + WS_SIN);
    { const int j = gt & 31;
      const float ex = (float)(2 * j) / 64.0f;
      const float pw = (float)exp((double)ex * 9.210340371976184);
      const float inv = 1.0f / pw;
      for (int i = gt; i < T * 32; i += NGT) { const int t = i >> 5;
          const float ang = (float)P.positions[t] * inv;
          float sn, cs; sincos_acc(ang, sn, cs); COS[i] = cs; SIN[i] = sn; } }
    { float* PART = (float*)(ws + WS_B1 + 4096); const int kv = tid >> 8, n = tid & 255;
      const float* pos = kv ? P.cmp_pos_v : P.cmp_pos_k; const float* w1 = kv ? P.cmp_w1_v : P.cmp_w1_k;
      float sacc = 0.f;
      for (int k0 = blockIdx.x; k0 < 2048; k0 += 8 * G) {
          float pv[8], wv[8];
#pragma unroll
          for (int e = 0; e < 8; ++e) { const int k = k0 + e * G; const bool ok = k < 2048; pv[e] = ok ? pos[k] : 0.f; wv[e] = ok ? w1[(size_t)k * 256 + n] : 0.f; }
#pragma unroll
          for (int e = 0; e < 8; ++e) sacc += pv[e] * wv[e]; }
      PART[(size_t)blockIdx.x * 512 + tid] = sacc; }
}

constexpr int CONV_UNITS = 128;
DI void conv_unit(const Params& P, LAS unsigned char* lds, int j) {
    int tq = threadIdx.x; asm volatile("" : "+v"(tq));
    const int lane = tq & 63, wave = __builtin_amdgcn_readfirstlane(tq >> 6);
    LAS float* scr = (LAS float*)(lds + wave * 16384);
    bf16_t* Wo_t = (bf16_t*)(P.ws + WS_WO); bf16_t* Wup_t = (bf16_t*)(P.ws + WS_WUP); bf16_t* Wdn_t = (bf16_t*)(P.ws + WS_WDN);
    constexpr int I_O = (DM / 64) * (DM / 32), I_UP = (DM / 64) * (MLPH / 32), I_DN = (MLPH / 64) * (DM / 32), PER = (I_O + I_UP + I_DN) / CONV_UNITS;
    static_assert((I_O + I_UP + I_DN) % CONV_UNITS == 0, "conversion items per unit");
    for (int it = j * PER + wave; it < (j + 1) * PER; it += 8) {
        int r = it;
        if (r < I_O) { transpose_item(P.w_o, DM, DM, Wo_t, P.mla_out_norm_w, P.nsa_out_norm_w, 1024, scr, r, lane, RowId()); continue; } r -= I_O;
        if (r < I_UP) { transpose_item(P.w_up, DM, MLPH, Wup_t, P.mlp_norm_w, P.mlp_norm_w, DM, scr, r, lane, RowId()); continue; } r -= I_UP;
        transpose_item(P.w_down, MLPH, DM, Wdn_t, nullptr, nullptr, 0, scr, r, lane, RowId());
    }
    __syncthreads();
}

DI f32x16 mfma32(bf16x8 a, bf16x8 b, f32x16 c) { return __builtin_amdgcn_mfma_f32_32x32x16_bf16(a, b, c, 0, 0, 0); }
typedef short v4i16_t __attribute__((ext_vector_type(4)));
DI s16x4 vtr(const LAS char* p) { return __builtin_bit_cast(s16x4, __builtin_amdgcn_ds_read_tr16_b64_v4i16((LAS v4i16_t*)p)); }
DI int crow(int r, int hi) { return (r & 3) + 8 * (r >> 2) + 4 * hi; }
#define CR(r) (((r) & 3) + 8 * ((r) >> 2))

template <int NKS, int PKB>
DI void qk_tile(const LAS char* Kt, const bf16x8* qf, int r32, int hi, f32x16& s0, f32x16& s1) {
    const LAS char* kb = Kt + r32 * PKB + hi * 16;
#pragma unroll
    for (int ks = 0; ks < NKS; ++ks) {
        const bf16x8 a0 = *(const LAS bf16x8*)(kb + ks * 32);
        const bf16x8 a1 = *(const LAS bf16x8*)(kb + 32 * PKB + ks * 32);
        s0 = mfma32(a0, qf[ks], s0); s1 = mfma32(a1, qf[ks], s1);
    }
}
template <int ND0, int PVB>
DI void pv_tile(const LAS char* Vt, const f32x16& p0, const f32x16& p1, f32x16* o, int lane) {
    const int hi = lane >> 5, q = (lane & 15) >> 2, p = lane & 3, blk = (lane >> 4) & 1;
    const LAS char* vb = Vt + (4 * hi + q) * PVB + (16 * blk + 4 * p) * 2;
    bf16x8 pa[4];
    { u32x4 w;
      w.x = pk2(p0[0], p0[1]); w.y = pk2(p0[2], p0[3]); w.z = pk2(p0[4], p0[5]); w.w = pk2(p0[6], p0[7]); pa[0] = __builtin_bit_cast(bf16x8, w);
      w.x = pk2(p0[8], p0[9]); w.y = pk2(p0[10], p0[11]); w.z = pk2(p0[12], p0[13]); w.w = pk2(p0[14], p0[15]); pa[1] = __builtin_bit_cast(bf16x8, w);
      w.x = pk2(p1[0], p1[1]); w.y = pk2(p1[2], p1[3]); w.z = pk2(p1[4], p1[5]); w.w = pk2(p1[6], p1[7]); pa[2] = __builtin_bit_cast(bf16x8, w);
      w.x = pk2(p1[8], p1[9]); w.y = pk2(p1[10], p1[11]); w.z = pk2(p1[12], p1[13]); w.w = pk2(p1[14], p1[15]); pa[3] = __builtin_bit_cast(bf16x8, w); }
    s16x4 lo[2][4], hh[2][4];
#pragma unroll
    for (int kk = 0; kk < 4; ++kk) { lo[0][kk] = vtr(vb + (16 * kk) * PVB); hh[0][kk] = vtr(vb + (16 * kk + 8) * PVB); }
#pragma unroll
    for (int d0 = 0; d0 < ND0; ++d0) {
        if (d0 + 1 < ND0) {
#pragma unroll
            for (int kk = 0; kk < 4; ++kk) { lo[(d0 + 1) & 1][kk] = vtr(vb + (16 * kk) * PVB + (d0 + 1) * 64); hh[(d0 + 1) & 1][kk] = vtr(vb + (16 * kk + 8) * PVB + (d0 + 1) * 64); }
        }
#pragma unroll
        for (int kk = 0; kk < 4; ++kk) {
            const s16x4 a = lo[d0 & 1][kk], b = hh[d0 & 1][kk];
            const bf16x8 vf = (bf16x8){a[0], a[1], a[2], a[3], b[0], b[1], b[2], b[3]};
            o[d0] = mfma32(pa[kk], vf, o[d0]);
        }
        __builtin_amdgcn_sched_barrier(0);
    }
}
template <int PKB>
DI void qk_tile4(const LAS char* Kt, const bf16x8* qf, int r32, int hi, f32x16& s0, f32x16& s1) {
    const LAS char* kb = Kt + r32 * PKB + hi * 16;
    bf16x8 a0[4], a1[4];
#pragma unroll
    for (int ks = 0; ks < 4; ++ks) { a0[ks] = *(const LAS bf16x8*)(kb + ks * 32); a1[ks] = *(const LAS bf16x8*)(kb + 32 * PKB + ks * 32); }
    __builtin_amdgcn_sched_barrier(0);
#pragma unroll
    for (int ks = 0; ks < 4; ++ks) { s0 = mfma32(a0[ks], qf[ks], s0); s1 = mfma32(a1[ks], qf[ks], s1); }
}
template <int PVB>
DI void pv_prefetch(const LAS char* Vt, int lane, s16x4* lo0, s16x4* hh0) {
    const int hi = lane >> 5, q = (lane & 15) >> 2, p = lane & 3, blk = (lane >> 4) & 1;
    const LAS char* vb = Vt + (4 * hi + q) * PVB + (16 * blk + 4 * p) * 2;
#pragma unroll
    for (int kk = 0; kk < 4; ++kk) { lo0[kk] = vtr(vb + (16 * kk) * PVB); hh0[kk] = vtr(vb + (16 * kk + 8) * PVB); }
    __builtin_amdgcn_sched_barrier(0);
}
template <int ND0, int PVB>
DI void pv_tile_pf(const LAS char* Vt, const f32x16& p0, const f32x16& p1, f32x16* o, int lane, const s16x4* lo0, const s16x4* hh0) {
    const int hi = lane >> 5, q = (lane & 15) >> 2, p = lane & 3, blk = (lane >> 4) & 1;
    const LAS char* vb = Vt + (4 * hi + q) * PVB + (16 * blk + 4 * p) * 2;
    bf16x8 pa[4];
    { u32x4 w;
      w.x = pk2(p0[0], p0[1]); w.y = pk2(p0[2], p0[3]); w.z = pk2(p0[4], p0[5]); w.w = pk2(p0[6], p0[7]); pa[0] = __builtin_bit_cast(bf16x8, w);
      w.x = pk2(p0[8], p0[9]); w.y = pk2(p0[10], p0[11]); w.z = pk2(p0[12], p0[13]); w.w = pk2(p0[14], p0[15]); pa[1] = __builtin_bit_cast(bf16x8, w);
      w.x = pk2(p1[0], p1[1]); w.y = pk2(p1[2], p1[3]); w.z = pk2(p1[4], p1[5]); w.w = pk2(p1[6], p1[7]); pa[2] = __builtin_bit_cast(bf16x8, w);
      w.x = pk2(p1[8], p1[9]); w.y = pk2(p1[10], p1[11]); w.z = pk2(p1[12], p1[13]); w.w = pk2(p1[14], p1[15]); pa[3] = __builtin_bit_cast(bf16x8, w); }
    s16x4 lo[2][4], hh[2][4];
#pragma unroll
    for (int kk = 0; kk < 4; ++kk) { lo[0][kk] = lo0[kk]; hh[0][kk] = hh0[kk]; }
#pragma unroll
    for (int d0 = 0; d0 < ND0; ++d0) {
        if (d0 + 1 < ND0) {
#pragma unroll
            for (int kk = 0; kk < 4; ++kk) { lo[(d0 + 1) & 1][kk] = vtr(vb + (16 * kk) * PVB + (d0 + 1) * 64); hh[(d0 + 1) & 1][kk] = vtr(vb + (16 * kk + 8) * PVB + (d0 + 1) * 64); }
        }
#pragma unroll
        for (int kk = 0; kk < 4; ++kk) {
            const s16x4 a = lo[d0 & 1][kk], b = hh[d0 & 1][kk];
            const bf16x8 vf = (bf16x8){a[0], a[1], a[2], a[3], b[0], b[1], b[2], b[3]};
            o[d0] = mfma32(pa[kk], vf, o[d0]);
        }
        __builtin_amdgcn_sched_barrier(0);
    }
}
DI float max3(float a, float b, float c) { float r; asm("v_max3_f32 %0, %1, %2, %3" : "=v"(r) : "v"(a), "v"(b), "v"(c)); return r; }
DI float rowmax32(const f32x16& s0, const f32x16& s1) {
    float a[10];
#pragma unroll
    for (int i = 0; i < 5; ++i) { a[i] = max3(s0[3 * i], s0[3 * i + 1], s0[3 * i + 2]); a[5 + i] = max3(s1[3 * i], s1[3 * i + 1], s1[3 * i + 2]); }
    const float b0 = max3(a[0], a[1], a[2]), b1 = max3(a[3], a[4], s0[15]), b2 = max3(a[5], a[6], a[7]), b3 = max3(a[8], a[9], s1[15]);
    return max3(max3(b0, b1, b2), b3, b3);
}
template <int ND0>
DI void online_update(f32x16& s0, f32x16& s1, float& m, float& l, f32x16* o, LAS float* wsf, int r32, int hi) {
    const float mx = max_halves(rowmax32(s0, s1));
    if (__any(mx > m + 8.f)) {
        const float mnew = fmaxf(m, mx);
        const float alpha = __builtin_amdgcn_exp2f(m - mnew);
        if constexpr (ND0 > 0) {
            if (hi == 0) wsf[r32] = alpha;
            asm volatile("s_waitcnt lgkmcnt(0)" ::: "memory");
#pragma unroll
            for (int r = 0; r < 16; ++r) { const float a = wsf[crow(r, hi)];
#pragma unroll
                for (int d = 0; d < ND0; ++d) o[d][r] *= a; }
            asm volatile("s_waitcnt lgkmcnt(0)" ::: "memory");
        }
        l *= alpha; m = mnew;
    }
    const float mref = m;
    float ls[4] = {0.f, 0.f, 0.f, 0.f};
#pragma unroll
    for (int r = 0; r < 16; ++r) { s0[r] = __builtin_amdgcn_exp2f(s0[r] - mref); s1[r] = __builtin_amdgcn_exp2f(s1[r] - mref); ls[r & 3] += s0[r] + s1[r]; }
    l += (ls[0] + ls[1]) + (ls[2] + ls[3]);
}

template <int ND0>
DI void online_update_rel(f32x16& s0, f32x16& s1, f32x16& negm, float& m, float& l, f32x16* o, LAS float* wsf, int r32, int hi, bool first) {
    const float mx = max_halves(rowmax32(s0, s1));
    if (first || __any(mx > 8.f)) {
        const float d = first ? mx : fmaxf(mx, 0.f);
        if (!first) {
            const float alpha = __builtin_amdgcn_exp2f(-d);
            if (hi == 0) wsf[r32] = alpha;
            asm volatile("s_waitcnt lgkmcnt(0)" ::: "memory");
#pragma unroll
            for (int r = 0; r < 16; ++r) { const float a = wsf[crow(r, hi)];
#pragma unroll
                for (int dd = 0; dd < ND0; ++dd) o[dd][r] *= a; }
            asm volatile("s_waitcnt lgkmcnt(0)" ::: "memory");
            l *= alpha;
        }
        m += d;
#pragma unroll
        for (int r = 0; r < 16; ++r) { negm[r] = -m; s0[r] -= d; s1[r] -= d; }
    }
#pragma unroll
    for (int r = 0; r < 16; ++r) { s0[r] = __builtin_amdgcn_exp2f(s0[r]); s1[r] = __builtin_amdgcn_exp2f(s1[r]); }
    float ls[4];
#pragma unroll
    for (int j = 0; j < 4; ++j) ls[j] = s0[j] + s1[j];
#pragma unroll
    for (int r = 4; r < 16; ++r) ls[r & 3] += s0[r] + s1[r];
    l += (ls[0] + ls[1]) + (ls[2] + ls[3]);
}

template <int PKB>
DI void qk_tile12(const LAS char* Kt, const bf16x8* qf, int r32, int hi, f32x16& s0, f32x16& s1) {
    const LAS char* kb = Kt + r32 * PKB + hi * 16;
    bf16x8 a0[2][2], a1[2][2];
#pragma unroll
    for (int j = 0; j < 2; ++j) { a0[0][j] = *(const LAS bf16x8*)(kb + j * 32); a1[0][j] = *(const LAS bf16x8*)(kb + 32 * PKB + j * 32); }
#pragma unroll
    for (int g = 0; g < 6; ++g) {
        if (g + 1 < 6) {
#pragma unroll
            for (int j = 0; j < 2; ++j) { a0[(g + 1) & 1][j] = *(const LAS bf16x8*)(kb + ((g + 1) * 2 + j) * 32); a1[(g + 1) & 1][j] = *(const LAS bf16x8*)(kb + 32 * PKB + ((g + 1) * 2 + j) * 32); }
        }
        __builtin_amdgcn_sched_barrier(0);
#pragma unroll
        for (int j = 0; j < 2; ++j) { s0 = mfma32(a0[g & 1][j], qf[g * 2 + j], s0); s1 = mfma32(a1[g & 1][j], qf[g * 2 + j], s1); }
        __builtin_amdgcn_sched_barrier(0);
    }
}

constexpr int MLA_PK = 400, MLA_PV = 320, MLA_KB = 64 * MLA_PK, MLA_VB = 64 * MLA_PV;
constexpr int MLA_WS = 2 * MLA_KB + 2 * MLA_VB;
constexpr int MLA_CS = 48;
DI constexpr int mla_nch(int qb) { return (4 * qb + 4 + MLA_CS - 1) / MLA_CS; }
DI constexpr int mla_pbase(int qb) { return qb < 12 ? 0 : (qb < 24 ? (qb - 12) * 2 : 24 + (qb - 24) * 3); }
constexpr size_t MLA_PART_BYTES = 256 * 128 * 2 + 256 * 2 * 4;
DI void mla_unit(const Params& P, LAS unsigned char* lds, int h, int qb, int c) {
    int tid_ = threadIdx.x; asm volatile("" : "+v"(tid_));
    const int tid = tid_, lane = tid & 63, wave = __builtin_amdgcn_readfirstlane(tid >> 6), r32 = lane & 31, hi = lane >> 5;
    const bf16_t* QM = (const bf16_t*)(P.ws + WS_QM); const bf16_t* KM = (const bf16_t*)(P.ws + WS_KM); const bf16_t* VM = (const bf16_t*)(P.ws + WS_VM);
    bf16_t* Y = (bf16_t*)(P.ws + WS_XN);
    LAS float* wsf = (LAS float*)(lds + MLA_WS + wave * 256);
    if (wave >= 4) __builtin_amdgcn_s_setprio(1);
    const int q0 = qb * 256 + wave * 32;
    bf16x8 qf[12];
    { const bf16_t* qp = QM + (size_t)(q0 + r32) * 1536 + h * 192 + hi * 8;
#pragma unroll
      for (int ks = 0; ks < 12; ++ks) qf[ks] = *(const bf16x8*)(qp + ks * 16); }
    f32x16 o[4];
#pragma unroll
    for (int d = 0; d < 4; ++d)
#pragma unroll
        for (int r = 0; r < 16; ++r) o[d][r] = 0.f;
    float m = 0.f, l = 0.f;
    f32x16 negm;
#pragma unroll
    for (int r = 0; r < 16; ++r) negm[r] = 0.f;
    const int NT = 4 * qb + 4, nch = mla_nch(qb), per = (NT + nch - 1) / nch;
    const int tb = c * per, te = (tb + per < NT) ? tb + per : NT;
    unsigned kgo[3], vgo[2], klo[3], vlo[2];
    { const int sr = tid >> 3, sc = tid & 7;
#pragma unroll
      for (int i = 0; i < 3; ++i) { kgo[i] = (unsigned)(sr * 1536 + (sc + 8 * i) * 8) * 2u; klo[i] = (unsigned)(sr * MLA_PK + (sc + 8 * i) * 16); }
#pragma unroll
      for (int i = 0; i < 2; ++i) { vgo[i] = (unsigned)(sr * 1024 + (sc + 8 * i) * 8) * 2u; vlo[i] = (unsigned)(2 * MLA_KB + sr * MLA_PV + (sc + 8 * i) * 16); } }
    const char* KMh = (const char*)(KM + h * 192); const char* VMh = (const char*)(VM + h * 128);
    u32x4 kreg[3], vreg[2];
#define MLA_LOAD(t) do { const char* kb_ = KMh + (size_t)(t) * (64 * 1536 * 2); const char* vb_ = VMh + (size_t)(t) * (64 * 1024 * 2); \
                         _Pragma("unroll") for (int i = 0; i < 3; ++i) kreg[i] = *(const u32x4*)(kb_ + kgo[i]); \
                         _Pragma("unroll") for (int i = 0; i < 2; ++i) vreg[i] = *(const u32x4*)(vb_ + vgo[i]); } while (0)
#define MLA_WRITE(b) do { _Pragma("unroll") for (int i = 0; i < 3; ++i) *(LAS u32x4*)(lds + (b) * MLA_KB + klo[i]) = kreg[i]; \
                          _Pragma("unroll") for (int i = 0; i < 2; ++i) *(LAS u32x4*)(lds + (b) * MLA_VB + vlo[i]) = vreg[i]; } while (0)
    MLA_LOAD(tb); MLA_WRITE(tb & 1);
    if (tb + 1 < te) MLA_LOAD(tb + 1);
    __syncthreads();
    for (int t = tb; t < te; ++t) {
        const int b = t & 1;
        if (t + 1 < te) { MLA_WRITE(b ^ 1); if (t + 2 < te) MLA_LOAD(t + 2); }
        const int k0 = t * 64;
        if (k0 <= q0 + 31) {
            f32x16 s0 = negm, s1 = negm;
            qk_tile12<MLA_PK>((const LAS char*)(lds + b * MLA_KB), qf, r32, hi, s0, s1);
            if (k0 + 63 > q0) {
                const int d0 = q0 + r32 - k0 - 4 * hi;
#pragma unroll
                for (int r = 0; r < 16; ++r) { if (CR(r) > d0) s0[r] = NEGBIG; if (CR(r) + 32 > d0) s1[r] = NEGBIG; }
            }
            s16x4 vlo[4], vhh[4]; pv_prefetch<MLA_PV>((const LAS char*)(lds + 2 * MLA_KB + b * MLA_VB), lane, vlo, vhh);
            online_update_rel<4>(s0, s1, negm, m, l, o, wsf, r32, hi, t == tb);
            pv_tile_pf<4, MLA_PV>((const LAS char*)(lds + 2 * MLA_KB + b * MLA_VB), s0, s1, o, lane, vlo, vhh);
        }
        __syncthreads();
    }
#undef MLA_LOAD
#undef MLA_WRITE
    const float lt = sum_halves(l);
    if (nch == 1) {
        if (hi == 0) wsf[r32] = 1.f / lt;
        asm volatile("s_waitcnt lgkmcnt(0)" ::: "memory");
#pragma unroll
        for (int r = 0; r < 16; ++r) {
            const int row = crow(r, hi); const float il = wsf[row];
#pragma unroll
            for (int d = 0; d < 4; ++d) Y[(size_t)(q0 + row) * DM + h * 128 + d * 32 + r32] = (bf16_t)(pk2(o[d][r] * il, 0.f) & 0xffffu);
        }
    } else {
        unsigned char* pp = (unsigned char*)P.out + (size_t)((mla_pbase(qb) + c) * 8 + h) * MLA_PART_BYTES;
        bf16_t* PO = (bf16_t*)pp; float* PML = (float*)(pp + 256 * 128 * 2);
        if (hi == 0) { PML[(wave * 32 + r32) * 2] = m; PML[(wave * 32 + r32) * 2 + 1] = lt; }
#pragma unroll
        for (int r = 0; r < 16; ++r) {
            const int row = wave * 32 + crow(r, hi);
#pragma unroll
            for (int d = 0; d < 4; ++d) PO[(size_t)row * 128 + d * 32 + r32] = (bf16_t)(pk2(o[d][r], 0.f) & 0xffffu);
        }
    }
    __builtin_amdgcn_s_setprio(0);
    __syncthreads();
}
struct MlaTable { unsigned short u[512]; int n; };
constexpr MlaTable make_mla_table() {
    MlaTable t{}; int cost[512] = {}; int n = 0;
    for (int qb = 31; qb >= 0; --qb) { const int NT = 4 * qb + 4, nch = mla_nch(qb), per = (NT + nch - 1) / nch;
        for (int c = 0; c < nch; ++c) { const int tb = c * per, te = (tb + per < NT) ? tb + per : NT;
            for (int h = 0; h < 8; ++h) { t.u[n] = (unsigned short)((qb << 8) | (c << 4) | h); cost[n] = te - tb; ++n; } } }
    for (int i = 1; i < n; ++i) { const unsigned short uu = t.u[i]; const int cc = cost[i]; int j = i - 1;
        while (j >= 0 && cost[j] < cc) { t.u[j + 1] = t.u[j]; cost[j + 1] = cost[j]; --j; }
        t.u[j + 1] = uu; cost[j + 1] = cc; }
    t.n = n; return t;
}
__device__ const MlaTable g_mla_table = make_mla_table();

constexpr int NSA_PK = 144, NSA_PV = 192, NSA_KB = 64 * NSA_PK, NSA_VB = 64 * NSA_PV, NSA_TB = NSA_KB + NSA_VB;
constexpr int NSA_WS = 2 * NSA_TB;
constexpr int NSA_WSZ = 4608 + 8192;
constexpr int NSA_BU = NSA_WS + 8 * NSA_WSZ;

DI void nsa_bias_mfma(f32x16& s0, f32x16& s1, unsigned qbw, unsigned qd2, unsigned qd3, unsigned uk0, unsigned uk1, int base, int hi) {
    const unsigned bb = __float_as_uint((float)base) >> 16;
    const unsigned w1 = hi == 0 ? (bb | (bb << 16)) : 0u, w2 = hi == 0 ? 0x3F803F80u : 0u, w3 = hi == 0 ? 0x3F80u : 0u;
    const u32x4 k0 = {uk0, w1, w2, w3}, k1 = {uk1, w1, w2, w3};
    const bf16x8 qfb = __builtin_bit_cast(bf16x8, ((u32x4){qbw, qbw, qd2, qd3}));
    s0 = mfma32(__builtin_bit_cast(bf16x8, k0), qfb, s0); s1 = mfma32(__builtin_bit_cast(bf16x8, k1), qfb, s1);
}
template <int ND0>
DI void online_update_k(f32x16& s0, f32x16& s1, float& m, unsigned& nh16, unsigned& nl, float& l, f32x16* o, LAS float* wsf, int r32, int hi, bool first) {
    const float mx = max_halves(rowmax32(s0, s1));
    if (first || __any(mx > 8.f)) {
        const float dt = mx > -1e29f ? (first ? mx : fmaxf(mx, 0.f)) : 0.f;
        const float neg = -(m + dt);
        const unsigned hb = pk2(neg, 0.f) & 0xffffu; const float fh = __uint_as_float(hb << 16);
        const unsigned lb = pk2(neg - fh, 0.f) & 0xffffu; const float fl = __uint_as_float(lb << 16);
        const bool ch = dt != 0.f;
        const float mnew = ch ? -(fh + fl) : m;
        const float d = mnew - m;
        if (!first) {
            const float alpha = __builtin_amdgcn_exp2f(-d);
            if constexpr (ND0 > 0) {
                if (hi == 0) wsf[r32] = alpha;
                asm volatile("s_waitcnt lgkmcnt(0)" ::: "memory");
#pragma unroll
                for (int r = 0; r < 16; ++r) { const float a = wsf[crow(r, hi)];
#pragma unroll
                    for (int dd = 0; dd < ND0; ++dd) o[dd][r] *= a; }
                asm volatile("s_waitcnt lgkmcnt(0)" ::: "memory");
            }
            l *= alpha;
        }
        if (ch) { nh16 = hi == 0 ? (hb << 16) : 0u; nl = hi == 0 ? lb : 0u; }
        m = mnew;
#pragma unroll
        for (int r = 0; r < 16; ++r) { s0[r] -= d; s1[r] -= d; }
    }
#pragma unroll
    for (int r = 0; r < 16; ++r) { s0[r] = __builtin_amdgcn_exp2f(s0[r]); s1[r] = __builtin_amdgcn_exp2f(s1[r]); }
    float ls[4];
#pragma unroll
    for (int j = 0; j < 4; ++j) ls[j] = s0[j] + s1[j];
#pragma unroll
    for (int r = 4; r < 16; ++r) ls[r & 3] += s0[r] + s1[r];
    l += (ls[0] + ls[1]) + (ls[2] + ls[3]);
}

DI void nsa_unit(const Params& P, LAS unsigned char* lds, int tile, int g) {
    int tid_ = threadIdx.x; asm volatile("" : "+v"(tid_));
    const int tid = tid_, lane = tid & 63, wave = __builtin_amdgcn_readfirstlane(tid >> 6), r32 = lane & 31, hi = lane >> 5;
    const unsigned char* ws = P.ws;
    const bf16_t* QN = (const bf16_t*)(ws + WS_QN);
    const bf16_t* KC = (const bf16_t*)(ws + WS_KC) + (size_t)g * 512 * 64; const bf16_t* VC = (const bf16_t*)(ws + WS_VC) + (size_t)g * 512 * 64;
    const bf16_t* KS = (const bf16_t*)(ws + WS_KVS) + (size_t)g * T * 64; const bf16_t* VS = (const bf16_t*)(ws + WS_KVS) + (size_t)(2 + g) * T * 64;
    const bf16_t* KW = (const bf16_t*)(ws + WS_KVW) + (size_t)g * T * 64; const bf16_t* VW = (const bf16_t*)(ws + WS_KVW) + (size_t)(2 + g) * T * 64;
    const float* GATE = (const float*)(ws + WS_GATE);
    bf16_t* Y = (bf16_t*)(P.ws + WS_XN); float* SSQN = (float*)(P.ws + WS_SSQN);
    LAS unsigned char* wsb = lds + NSA_WS + wave * NSA_WSZ;
    LAS float* wsf = (LAS float*)wsb; LAS unsigned* selm = (LAS unsigned*)(wsb + 128); LAS float* AE = (LAS float*)(wsb + 512);
    LAS unsigned* BU = (LAS unsigned*)(lds + NSA_BU);

    const int t0 = tile * 32, cur = t0 >> 6;
    const int tokl = r32 >> 3, head = r32 & 7, hidx = g * 8 + head;
    const int t = t0 + wave * 4 + tokl;
    const float sl2 = __builtin_amdgcn_exp2f(-0.5f * (float)(hidx + 1)) * LOG2E;
    const unsigned slh = pk2(sl2, 0.f) & 0xffffu; const unsigned sll = pk2(sl2 - __uint_as_float(slh << 16), 0.f) & 0xffffu;
    const unsigned qbw = hi == 0 ? (slh | (sll << 16)) : 0u;
    const unsigned qmask = hi == 0 ? 0xF14Au : 0u;
    const unsigned uks0 = hi == 0 ? pk2((float)r32, (float)r32) : 0u, uks1 = hi == 0 ? pk2((float)(r32 + 32), (float)(r32 + 32)) : 0u;
    const unsigned ukc0 = hi == 0 ? pk2((float)(16 * r32), (float)(16 * r32)) : 0u, ukc1 = hi == 0 ? pk2((float)(16 * r32 + 512), (float)(16 * r32 + 512)) : 0u;
    bf16x8 qf[4];
    { const bf16_t* qp = QN + (size_t)t * 1024 + hidx * 64 + hi * 8;
#pragma unroll
      for (int ks = 0; ks < 4; ++ks) qf[ks] = *(const bf16x8*)(qp + ks * 16); }
    if (tid < 4) BU[tid] = 0u;
    LAS float* yl = (LAS float*)(wsb + 4608) + lane;
    const float gc = GATE[(size_t)t * 48 + hidx * 3 + 0], gs = GATE[(size_t)t * 48 + hidx * 3 + 1], gw = GATE[(size_t)t * 48 + hidx * 3 + 2];

    const int srow = tid >> 3, sch = tid & 7, soff = srow * 64 + sch * 8;
    u32x4 kreg, vreg; int par = 0;
#define NSA_LDK(base) kreg = *(const u32x4*)((base) + soff)
#define NSA_LDV(base) vreg = *(const u32x4*)((base) + soff)
#define NSA_WRK() *(LAS u32x4*)(lds + par * NSA_TB + srow * NSA_PK + sch * 16) = kreg
#define NSA_WRV() *(LAS u32x4*)(lds + par * NSA_TB + NSA_KB + srow * NSA_PV + sch * 16) = vreg
#define NSA_KT ((const LAS char*)(lds + par * NSA_TB))
#define NSA_VT ((const LAS char*)(lds + par * NSA_TB + NSA_KB))

    const int ntc = ((t0 >> 4) + 1 + 63) >> 6;
    float mc = 0.f, lc = 0.f; unsigned nh16 = 0u, nl = 0u;
    NSA_LDK(KC);
    for (int i = 0; i < ntc; ++i) {
        const int n0 = 64 * i;
        NSA_WRK();
        __syncthreads();
        if (i + 1 < ntc) NSA_LDK(KC + (size_t)(n0 + 64) * 64); else { NSA_LDK(KC); NSA_LDV(VC); }
        f32x16 s0, s1;
#pragma unroll
        for (int r = 0; r < 16; ++r) { s0[r] = 0.f; s1[r] = 0.f; }
        qk_tile4<NSA_PK>(NSA_KT, qf, r32, hi, s0, s1);
        const int db = t - 31 - 16 * (n0 + 4 * hi);
        nsa_bias_mfma(s0, s1, qbw, nh16, nl, ukc0, ukc1, 1024 * (i - (ntc - 1)), hi);
        if (16 * (n0 + 63) + 31 > t0) {
#pragma unroll
            for (int r = 0; r < 16; ++r) { if (16 * CR(r) > db) s0[r] = NEGBIG; if (16 * CR(r) + 512 > db) s1[r] = NEGBIG; }
        }
        online_update_k<0>(s0, s1, mc, nh16, nl, lc, nullptr, wsf, r32, hi, i == 0);
        par ^= 1;
    }
    const float lct = sum_halves(lc);
    const float ilc = (t >= 31) ? 1.f / lct : 0.f;
    f32x16 oc[2];
#pragma unroll
    for (int d = 0; d < 2; ++d)
#pragma unroll
        for (int r = 0; r < 16; ++r) oc[d][r] = 0.f;
    for (int i = 0; i < ntc; ++i) {
        const int n0 = 64 * i;
        NSA_WRK(); NSA_WRV();
        __syncthreads();
        if (i + 1 < ntc) { NSA_LDK(KC + (size_t)(n0 + 64) * 64); NSA_LDV(VC + (size_t)(n0 + 64) * 64); }
        else { NSA_LDK(KS + (size_t)cur * 64 * 64); NSA_LDV(VS + (size_t)cur * 64 * 64); }
        f32x16 s0, s1;
#pragma unroll
        for (int r = 0; r < 16; ++r) { s0[r] = 0.f; s1[r] = 0.f; }
        qk_tile4<NSA_PK>(NSA_KT, qf, r32, hi, s0, s1);
        const int db = t - 31 - 16 * (n0 + 4 * hi);
        nsa_bias_mfma(s0, s1, qbw, nh16, nl, ukc0, ukc1, 1024 * (i - (ntc - 1)), hi);
        s16x4 vlo[4], vhh[4]; pv_prefetch<NSA_PV>(NSA_VT, lane, vlo, vhh);
        if (16 * (n0 + 63) + 31 > t0) {
#pragma unroll
            for (int r = 0; r < 16; ++r) { if (16 * CR(r) > db) s0[r] = NEGBIG; if (16 * CR(r) + 512 > db) s1[r] = NEGBIG; }
        }
#pragma unroll
        for (int r = 0; r < 16; ++r) { s0[r] = __builtin_amdgcn_exp2f(s0[r]) * ilc; s1[r] = __builtin_amdgcn_exp2f(s1[r]) * ilc; }
        { float av[8], ev[8];
#pragma unroll
          for (int kh = 0; kh < 2; ++kh)
#pragma unroll
              for (int qd = 0; qd < 4; ++qd) { const f32x16& s = kh ? s1 : s0;
                  av[kh * 4 + qd] = (s[4 * qd] + s[4 * qd + 1]) + (s[4 * qd + 2] + s[4 * qd + 3]); ev[kh * 4 + qd] = s[4 * qd + 3]; }
#pragma unroll
          for (int k = 0; k < 8; ++k) { av[k] = dpp_f<0xB1>(av[k]) + av[k]; ev[k] = dpp_f<0xB1>(ev[k]) + ev[k]; }
#pragma unroll
          for (int k = 0; k < 8; ++k) { av[k] = dpp_f<0x4E>(av[k]) + av[k]; ev[k] = dpp_f<0x4E>(ev[k]) + ev[k]; }
#pragma unroll
          for (int k = 0; k < 8; ++k) { av[k] = dpp_f<0x141>(av[k]) + av[k]; ev[k] = dpp_f<0x141>(ev[k]) + ev[k]; }
          if (head == 0) {
#pragma unroll
              for (int kh = 0; kh < 2; ++kh)
#pragma unroll
                  for (int qd = 0; qd < 4; ++qd) { const int blk = 16 * i + 8 * kh + 2 * qd + hi; AE[tokl * 128 + blk] = av[kh * 4 + qd]; AE[512 + tokl * 128 + blk] = ev[kh * 4 + qd]; }
          } }
        pv_tile_pf<2, NSA_PV>(NSA_VT, s0, s1, oc, lane, vlo, vhh);
        par ^= 1;
    }
    if (hi == 0) wsf[r32] = gc;
    asm volatile("s_waitcnt lgkmcnt(0)" ::: "memory");
#pragma unroll
    for (int r = 0; r < 16; ++r) { const float a = wsf[crow(r, hi)]; yl[r * 64] = oc[0][r] * a; yl[(16 + r) * 64] = oc[1][r] * a; }
    asm volatile("s_waitcnt lgkmcnt(0)" ::: "memory");

    unsigned wu0 = 0u, wu1 = 0u, wu2 = 0u, wu3 = 0u;
    if (cur < 16) {
        wu0 = (2u << cur) - 1u;
        if (lane < 16) selm[lane] = (lane & 3) == 0 ? wu0 : 0u;
    } else {
        unsigned f0 = 1u, f1 = 0u, f2 = 0u, f3 = 0u;
        { const int b = cur; if (b < 32) f0 |= 1u << b; else if (b < 64) f1 |= 1u << (b - 32); else if (b < 96) f2 |= 1u << (b - 64); else f3 |= 1u << (b - 96); }
        { const int b = cur - 1; if (b < 32) f0 |= 1u << b; else if (b < 64) f1 |= 1u << (b - 32); else if (b < 96) f2 |= 1u << (b - 64); else f3 |= 1u << (b - 96); }
        unsigned key0[4], key1[4];
#pragma unroll
        for (int tk = 0; tk < 4; ++tk) {
            key0[tk] = 0u; key1[tk] = 0u;
            { const int sb = lane; if (sb >= 1 && sb <= cur - 2) key0[tk] = __float_as_uint(AE[tk * 128 + sb] + AE[512 + tk * 128 + sb - 1]); }
            { const int sb = lane + 64; if (sb <= cur - 2) key1[tk] = __float_as_uint(AE[tk * 128 + sb] + AE[512 + tk * 128 + sb - 1]); }
        }
        const unsigned long long val0 = __ballot(lane >= 1 && lane <= cur - 2), val1 = __ballot(lane + 64 <= cur - 2);
        unsigned thr[4] = {0u, 0u, 0u, 0u};
#pragma unroll 1
        for (int bit = 30; bit >= 0; --bit) {
#pragma unroll
            for (int tk = 0; tk < 4; ++tk) {
                const unsigned cand = thr[tk] | (1u << bit);
                const int cnt = __popcll(__ballot(key0[tk] >= cand)) + __popcll(__ballot(key1[tk] >= cand));
                if (cnt >= 13) thr[tk] = cand;
            }
        }
#pragma unroll
        for (int tk = 0; tk < 4; ++tk) {
            unsigned long long g0 = __ballot(key0[tk] > thr[tk]) & val0, g1 = __ballot(key1[tk] > thr[tk]) & val1;
            unsigned long long e0 = __ballot(key0[tk] == thr[tk]) & val0, e1 = __ballot(key1[tk] == thr[tk]) & val1;
            int need = 13 - (__popcll(g0) + __popcll(g1));
#pragma unroll 1
            for (; need > 0; --need) { if (e0) { const unsigned long long bq = e0 & (0ull - e0); g0 |= bq; e0 ^= bq; } else { const unsigned long long bq = e1 & (0ull - e1); g1 |= bq; e1 ^= bq; } }
            const unsigned mk0 = __builtin_amdgcn_readfirstlane(f0 | (unsigned)g0), mk1 = __builtin_amdgcn_readfirstlane(f1 | (unsigned)(g0 >> 32)),
                           mk2 = __builtin_amdgcn_readfirstlane(f2 | (unsigned)g1), mk3 = __builtin_amdgcn_readfirstlane(f3 | (unsigned)(g1 >> 32));
            if (lane == 0) { selm[tk * 4 + 0] = mk0; selm[tk * 4 + 1] = mk1; selm[tk * 4 + 2] = mk2; selm[tk * 4 + 3] = mk3; }
            wu0 |= mk0; wu1 |= mk1; wu2 |= mk2; wu3 |= mk3;
        }
    }
    if (lane == 0) { atomicOr((unsigned*)&BU[0], wu0); atomicOr((unsigned*)&BU[1], wu1); atomicOr((unsigned*)&BU[2], wu2); atomicOr((unsigned*)&BU[3], wu3); }
    asm volatile("s_waitcnt lgkmcnt(0)" ::: "memory");
    const unsigned ms0 = selm[tokl * 4 + 0], ms1 = selm[tokl * 4 + 1], ms2 = selm[tokl * 4 + 2], ms3 = selm[tokl * 4 + 3];
    __syncthreads();
    unsigned bu[4]; bu[0] = __builtin_amdgcn_readfirstlane(BU[0]); bu[1] = __builtin_amdgcn_readfirstlane(BU[1]); bu[2] = __builtin_amdgcn_readfirstlane(BU[2]); bu[3] = __builtin_amdgcn_readfirstlane(BU[3]);

    {
        f32x16 o[2];
#pragma unroll
        for (int d = 0; d < 2; ++d)
#pragma unroll
            for (int r = 0; r < 16; ++r) o[d][r] = 0.f;
        float m = 0.f, l = 0.f; nh16 = 0u; nl = 0u; bool first = true;
        if (cur < 32) bu[0] &= ~(1u << cur); else if (cur < 64) bu[1] &= ~(1u << (cur - 32)); else if (cur < 96) bu[2] &= ~(1u << (cur - 64)); else bu[3] &= ~(1u << (cur - 96));
#define NSA_NEXT(nb) do { nb = -1; \
            if (bu[3]) nb = 127 - __builtin_clz(bu[3]); else if (bu[2]) nb = 95 - __builtin_clz(bu[2]); else if (bu[1]) nb = 63 - __builtin_clz(bu[1]); else if (bu[0]) nb = 31 - __builtin_clz(bu[0]); \
            if (nb >= 0) { if (nb < 32) bu[0] &= ~(1u << nb); else if (nb < 64) bu[1] &= ~(1u << (nb - 32)); else if (nb < 96) bu[2] &= ~(1u << (nb - 64)); else bu[3] &= ~(1u << (nb - 96)); } } while (0)
#define NSA_SEL_COMPUTE(b) do { \
            const unsigned wuw = b < 32 ? wu0 : (b < 64 ? wu1 : (b < 96 ? wu2 : wu3)); \
            if ((wuw >> (b & 31)) & 1u) { \
                const unsigned msw = b < 32 ? ms0 : (b < 64 ? ms1 : (b < 96 ? ms2 : ms3)); \
                const bool selme = (msw >> (b & 31)) & 1u; \
                f32x16 s0, s1; \
                _Pragma("unroll") for (int r = 0; r < 16; ++r) { s0[r] = 0.f; s1[r] = 0.f; } \
                qk_tile4<NSA_PK>(NSA_KT, qf, r32, hi, s0, s1); \
                const int db = t - 64 * b - 4 * hi;            \
                nsa_bias_mfma(s0, s1, qbw, (selme ? 0u : qmask) | nh16, nl, uks0, uks1, 64 * (b - cur), hi); \
                s16x4 vlo[4], vhh[4]; pv_prefetch<NSA_PV>(NSA_VT, lane, vlo, vhh); \
                if (b == cur) { \
                    _Pragma("unroll") for (int r = 0; r < 16; ++r) { if (CR(r) > db) s0[r] = NEGBIG; if (CR(r) + 32 > db) s1[r] = NEGBIG; } \
                } \
                online_update_k<2>(s0, s1, m, nh16, nl, l, o, wsf, r32, hi, first); first = false; \
                pv_tile_pf<2, NSA_PV>(NSA_VT, s0, s1, o, lane, vlo, vhh); \
            } } while (0)
        u32x4 kreg2, vreg2;
#define NSA_LD2(kp, vp) do { kreg2 = *(const u32x4*)((kp) + soff); vreg2 = *(const u32x4*)((vp) + soff); } while (0)
#define NSA_WR2() do { *(LAS u32x4*)(lds + par * NSA_TB + srow * NSA_PK + sch * 16) = kreg2; *(LAS u32x4*)(lds + par * NSA_TB + NSA_KB + srow * NSA_PV + sch * 16) = vreg2; } while (0)
        int bA = cur, bB; NSA_NEXT(bB);
        if (bB >= 0) NSA_LD2(KS + (size_t)bB * 64 * 64, VS + (size_t)bB * 64 * 64); else NSA_LD2(KW + (size_t)cur * 64 * 64, VW + (size_t)cur * 64 * 64);
        for (;;) {
            NSA_WRK(); NSA_WRV();
            __syncthreads();
            int bC = -1;
            if (bB >= 0) { NSA_NEXT(bC);
                if (bC >= 0) { NSA_LDK(KS + (size_t)bC * 64 * 64); NSA_LDV(VS + (size_t)bC * 64 * 64); } else { NSA_LDK(KW + (size_t)cur * 64 * 64); NSA_LDV(VW + (size_t)cur * 64 * 64); } }
            NSA_SEL_COMPUTE(bA);
            par ^= 1;
            if (bB < 0) { kreg = kreg2; vreg = vreg2; break; }
            NSA_WR2();
            __syncthreads();
            int bD = -1;
            if (bC >= 0) { NSA_NEXT(bD);
                if (bD >= 0) NSA_LD2(KS + (size_t)bD * 64 * 64, VS + (size_t)bD * 64 * 64); else NSA_LD2(KW + (size_t)cur * 64 * 64, VW + (size_t)cur * 64 * 64); }
            NSA_SEL_COMPUTE(bB);
            par ^= 1;
            if (bC < 0) break;
            bA = bC; bB = bD;
        }
#undef NSA_LD2
#undef NSA_WR2
#undef NSA_NEXT
#undef NSA_SEL_COMPUTE
        const float lt = sum_halves(l);
        if (hi == 0) wsf[r32] = gs / lt;
        asm volatile("s_waitcnt lgkmcnt(0)" ::: "memory");
#pragma unroll
        for (int r = 0; r < 16; ++r) { const float a = wsf[crow(r, hi)]; yl[r * 64] += o[0][r] * a; yl[(16 + r) * 64] += o[1][r] * a; }
        asm volatile("s_waitcnt lgkmcnt(0)" ::: "memory");
    }
    {
        f32x16 o[2];
#pragma unroll
        for (int d = 0; d < 2; ++d)
#pragma unroll
            for (int r = 0; r < 16; ++r) o[d][r] = 0.f;
        float m = 0.f, l = 0.f; nh16 = 0u; nl = 0u;
        const int ktlo = (t0 - 511) > 0 ? ((t0 - 511) >> 6) : 0;
        for (int kt = cur; kt >= ktlo; --kt) {
            NSA_WRK(); NSA_WRV();
            __syncthreads();
            if (kt > ktlo) { NSA_LDK(KW + (size_t)(kt - 1) * 64 * 64); NSA_LDV(VW + (size_t)(kt - 1) * 64 * 64); }
            f32x16 s0, s1;
#pragma unroll
            for (int r = 0; r < 16; ++r) { s0[r] = 0.f; s1[r] = 0.f; }
            qk_tile4<NSA_PK>(NSA_KT, qf, r32, hi, s0, s1);
            const int db = t - 64 * kt - 4 * hi;
            nsa_bias_mfma(s0, s1, qbw, nh16, nl, uks0, uks1, 64 * (kt - cur), hi);
            s16x4 vlo[4], vhh[4]; pv_prefetch<NSA_PV>(NSA_VT, lane, vlo, vhh);
            if (kt == cur) {
#pragma unroll
                for (int r = 0; r < 16; ++r) { if (CR(r) > db) s0[r] = NEGBIG; if (CR(r) + 32 > db) s1[r] = NEGBIG; }
            }
            if (t0 + 31 - 64 * kt >= 512) {
#pragma unroll
                for (int r = 0; r < 16; ++r) { if (db - CR(r) >= 512) s0[r] = NEGBIG; if (db - 32 - CR(r) >= 512) s1[r] = NEGBIG; }
            }
            online_update_k<2>(s0, s1, m, nh16, nl, l, o, wsf, r32, hi, kt == cur);
            pv_tile_pf<2, NSA_PV>(NSA_VT, s0, s1, o, lane, vlo, vhh);
            par ^= 1;
        }
        const float lt = sum_halves(l);
        if (hi == 0) wsf[r32] = gw / lt;
        asm volatile("s_waitcnt lgkmcnt(0)" ::: "memory");
#pragma unroll
        for (int r = 0; r < 16; ++r) { const float a = wsf[crow(r, hi)]; yl[r * 64] += o[0][r] * a; yl[(16 + r) * 64] += o[1][r] * a; }
        asm volatile("s_waitcnt lgkmcnt(0)" ::: "memory");
    }
#undef NSA_LDK
#undef NSA_LDV
#undef NSA_WRK
#undef NSA_WRV
#undef NSA_KT
#undef NSA_VT
    float ssq[4];
#pragma unroll
    for (int tk = 0; tk < 4; ++tk) ssq[tk] = 0.f;
#pragma unroll
    for (int r = 0; r < 16; ++r) {
        const int tk = r >> 2, hd = (r & 3) + 4 * hi;
#pragma unroll
        for (int d = 0; d < 2; ++d) { const float y = yl[(d * 16 + r) * 64]; ssq[tk] += y * y;
            Y[(size_t)(t0 + wave * 4 + tk) * DM + 1024 + (g * 8 + hd) * 64 + d * 32 + r32] = (bf16_t)(pk2(y, 0.f) & 0xffffu); }
    }
#pragma unroll
    for (int tk = 0; tk < 4; ++tk) { const float s = wave_sum(ssq[tk]); if (lane == 0) SSQN[(size_t)(t0 + wave * 4 + tk) * 2 + g] = s; }
    __syncthreads();
}

#define XB_TMO      128
#define XB_XCNT(j)  (256  + 64 * (j))
#define XB_XSUB(j)  (1280 + 64 * (j))
#define XB_XGEN(j)  (2304 + 64 * (j))
#define XB_TOP      3328
#define XB_TOPGEN   3392
#define XCD_BAR_WORDS 3456
#define XB_SPIN_CAP (1u << 18)
DI unsigned xb_ld(unsigned* p)              { return __hip_atomic_load(p, __ATOMIC_RELAXED, __HIP_MEMORY_SCOPE_AGENT); }
DI unsigned xb_add(unsigned* p, unsigned v) { return __hip_atomic_fetch_add(p, v, __ATOMIC_RELAXED, __HIP_MEMORY_SCOPE_AGENT); }
DI unsigned xb_xcc_id() { return (unsigned)__builtin_amdgcn_s_getreg((3 << 11) | 20) & 0xFu; }
#define XB_SPIN(cond, bar) do { unsigned _sp = 0; while (cond) { __builtin_amdgcn_s_sleep(1); \
    if ((++_sp & 255u) == 0u) { if (xb_ld(&(bar)[XB_TMO])) break; if (_sp > XB_SPIN_CAP) { atomicAdd(&(bar)[XB_TMO], 1u); break; } } } } while (0)
struct XcdBarrier { unsigned* bar; unsigned x; volatile LAS unsigned* st; };
DI XcdBarrier xcd_barrier_post(unsigned* bar, volatile LAS unsigned* st) {
    XcdBarrier b; b.bar = bar; b.x = xb_xcc_id(); b.st = st;
    if (threadIdx.x == 0) (void)xb_add(&bar[XB_XCNT(b.x)], 1u);
    return b;
}
DI void xcd_barrier_complete(unsigned* bar, unsigned x, unsigned& nloc, unsigned& nx) {
    const unsigned G = gridDim.x * gridDim.y * gridDim.z;
    unsigned sum, cnt, mine, sp = 0u;
    for (;;) {
        sum = 0u; cnt = 0u; mine = 0u;
#pragma unroll
        for (unsigned j = 0; j < 16; ++j) { const unsigned c = xb_ld(&bar[XB_XCNT(j)]); sum += c; cnt += (c > 0u) ? 1u : 0u; mine = (j == x) ? c : mine; }
        if (sum == G) break;
        __builtin_amdgcn_s_sleep(1);
        if ((++sp & 255u) == 0u) { if (xb_ld(&bar[XB_TMO])) break; if (sp > XB_SPIN_CAP) { atomicAdd(&bar[XB_TMO], 1u); break; } }
    }
    nloc = mine > 0u ? mine : 1u; nx = cnt > 0u ? cnt : 1u;
}
DI void xcd_barrier(const XcdBarrier& b) {
    asm volatile("s_waitcnt vmcnt(0)" ::: "memory");
    __syncthreads();
    if (threadIdx.x == 0) {
        unsigned* bar = b.bar;
        __builtin_amdgcn_s_waitcnt(0);
        unsigned nloc = b.st[0], nx = b.st[1];
        if (nloc == 0u) { xcd_barrier_complete(bar, b.x, nloc, nx); b.st[0] = nloc; b.st[1] = nx; }
        const unsigned old = xb_add(&bar[XB_XSUB(b.x)], 1u);
        const unsigned gen = old / nloc;
        if (old + 1u == (gen + 1u) * nloc) {
            __builtin_amdgcn_fence(__ATOMIC_RELEASE, "agent");
            asm volatile("s_waitcnt vmcnt(0)" ::: "memory");
            const unsigned og = xb_add(&bar[XB_TOP], 1u);
            const unsigned tg = og / nx;
            if (og + 1u == (tg + 1u) * nx) xb_add(&bar[XB_TOPGEN], 1u);
            else XB_SPIN(xb_ld(&bar[XB_TOPGEN]) == tg, bar);
            __builtin_amdgcn_fence(__ATOMIC_ACQUIRE, "agent");
            xb_add(&bar[XB_XGEN(b.x)], 1u);
            asm volatile("s_waitcnt vmcnt(0)" ::: "memory");
        } else {
            XB_SPIN(xb_ld(&bar[XB_XGEN(b.x)]) == gen, bar);
            __builtin_amdgcn_fence(__ATOMIC_ACQUIRE, "agent");
            asm volatile("s_waitcnt vmcnt(0)" ::: "memory");
        }
    }
    __syncthreads();
}

__global__ void __launch_bounds__(512, 2) mega_fwd(Params P) {
    extern __shared__ __attribute__((aligned(16))) unsigned char lds_raw[];
    LAS unsigned char* lds = (LAS unsigned char*)lds_raw;
    const int G = gridDim.x, tid = threadIdx.x, lane = tid & 63, wave = __builtin_amdgcn_readfirstlane(tid >> 6);
    unsigned char* ws = P.ws;
    if (tid < 8) ((LAS unsigned*)(lds + LDS_BYTES - 32))[tid] = 0u;
    __syncthreads();
#ifdef PROBE
    unsigned long long* TS = (unsigned long long*)(ws + WS_CTL + 32768);
#define STAMP(k) do { if (blockIdx.x == 0 && tid == 0) TS[k] = __builtin_amdgcn_s_memrealtime(); } while (0)
#else
#define STAMP(k) do {} while (0)
#endif
    STAMP(0);
    const XcdBarrier bar = xcd_barrier_post((unsigned*)(ws + WS_CTL) + 4096, (volatile LAS unsigned*)(lds + LDS_BYTES - 32));
    p0_prep(P, lds, G);
    xcd_barrier(bar); STAMP(1);
    if (G == 256) {
        if (blockIdx.x == G - 1) { const float* PART = (const float*)(ws + WS_B1 + 4096); float sacc = 0.f;
            for (int b = 0; b < G; ++b) sacc += PART[(size_t)b * 512 + tid];
            ((float*)(ws + WS_B1))[tid] = sacc; }
        unsigned* cnt1 = (unsigned*)(ws + WS_CTL) + 192; unsigned* ctr2 = (unsigned*)(ws + WS_CTL) + 128;
        {
            pg8::Gemm g{(const bf16_t*)(ws + WS_XN), (const bf16_t*)(ws + WS_WIN), DM, DM, DM};
            pg8::OrderP1 S{(int)blockIdx.x, cnt1, (unsigned*)(ws + WS_CTL) + 512};
            EpiIn E{0, (bf16_t*)(ws + WS_CQ), (bf16_t*)(ws + WS_CKV), (bf16_t*)(ws + WS_QN), (bf16_t*)(ws + WS_KVC), (bf16_t*)(ws + WS_KVS), (bf16_t*)(ws + WS_KVW),
                    (float*)(ws + WS_KR), (float*)(ws + WS_GATE), (float*)(ws + WS_SSQQ), (float*)(ws + WS_SSQKV)};
            pg8::gemm_phase(lds, g, S, E);
        }
        STAMP(2);
        unsigned* pcnt = (unsigned*)(ws + WS_CTL) + 512;
        LAS int* ubox = (LAS int*)(lds + LDS_BYTES - 16);
        bool all_in = false;
        for (;;) {
            if (tid == 0) *ubox = (int)atomicAdd(ctr2, 1u);
            __syncthreads();
            const int q = __builtin_amdgcn_readfirstlane(*ubox);
            __syncthreads();
            if (!all_in) {
                if (tid == 0) {
                    int fl = 1;
                    if (__hip_atomic_load(cnt1, __ATOMIC_RELAXED, __HIP_MEMORY_SCOPE_AGENT) < 256u) {
                        fl = 0;
                        int kind, p0, p1; unsigned need;
                        if (q < 8) { kind = 3; p0 = 16 * (q & 3); p1 = p0 + 16 < 31 ? p0 + 16 : 31; need = 2u; }
                        else if (q < 200) { kind = 0; p0 = p1 = (q - 8) & 31; need = 2u; }
                        else if (q < 456) { kind = 1; p0 = p1 = (q - 200) & 31; need = 1u; }
                        else if (q < 712) { kind = 2; p0 = p1 = (q - 456) >> 3; need = 1u; }
                        else { kind = 0; p0 = 0; p1 = -1; need = 0u; }
                        unsigned sp = 0;
                        for (int p = p0; p <= p1; ++p)
                            while (__hip_atomic_load(pcnt + (kind * 32 + p) * 4, __ATOMIC_RELAXED, __HIP_MEMORY_SCOPE_AGENT) < need) { __builtin_amdgcn_s_sleep(4); if (++sp > (1u << 22)) break; }
                    }
                    __builtin_amdgcn_fence(__ATOMIC_ACQUIRE, "agent"); asm volatile("s_waitcnt vmcnt(0)" ::: "memory");
                    ubox[1] = fl;
                }
                __syncthreads();
                all_in = __builtin_amdgcn_readfirstlane(ubox[1]) != 0;
                __syncthreads();
            }
            if (q >= 8 + 192 + 256 + 256) break;
            if (q >= 8 && q < 200) { const int v = q - 8;
                pg8::Gemm g{(const bf16_t*)(ws + WS_CQ), (const bf16_t*)(ws + WS_WUQ), QRANK, QRANK, QRANK};
                pg8::OneUnit S{Unit{v & 31, v >> 5, 0}};
                EpiQ E{0, (bf16_t*)(ws + WS_QM), (const float*)(ws + WS_SSQQ), (const float*)(ws + WS_COS), (const float*)(ws + WS_SIN)};
                pg8::gemm_phase(lds, g, S, E);
            } else if (q >= 200 && q < 456) { const int v = q - 200;
                pg8::Gemm g{(const bf16_t*)(ws + WS_CKV), (const bf16_t*)(ws + WS_WUKV), KVRANK, KVRANK, KVRANK};
                pg8::OneUnit S{Unit{v & 31, v >> 5, 0}};
                EpiKV E{0, (bf16_t*)(ws + WS_KM), (bf16_t*)(ws + WS_VM), (const float*)(ws + WS_SSQKV)};
                pg8::gemm_phase(lds, g, S, E);
            } else if (q < 8) { const int kv = q >> 2;
                pg8::Gemm g{(const bf16_t*)(ws + WS_KVC) + (size_t)kv * 2 * T * 64, (const bf16_t*)(ws + (kv ? WS_W1V : WS_W1K)), 1024, 2048, 2048};
                pg8::OneUnit S{Unit{q & 3, 0, 0}};
                EpiPart E{0, (float*)(ws + WS_PARTH) + (size_t)kv * 8 * 1024 * 256};
                pg8::gemm_phase(lds, g, S, E);
            } else { const int ch = q - 456;
                const float* KR = (const float*)(ws + WS_KR); const float* COS = (const float*)(ws + WS_COS); const float* SIN = (const float*)(ws + WS_SIN);
                bf16_t* KM = (bf16_t*)(ws + WS_KM);
                for (int i = ch * 1024 + tid; i < (ch + 1) * 1024; i += 512) { const int t = i >> 5, j = i & 31;
                    const float x1 = KR[(size_t)t * 64 + j], x2 = KR[(size_t)t * 64 + 32 + j], c = COS[i], sn = SIN[i];
                    const unsigned w = pk2(x1 * c - x2 * sn, x2 * c + x1 * sn);
#pragma unroll
                    for (int h = 0; h < 8; ++h) *(unsigned*)(KM + (size_t)t * 1536 + h * 192 + 128 + 2 * j) = w; }
            }
        }
    }
    xcd_barrier(bar); STAMP(3);
    {
        LAS float* HL = (LAS float*)lds;
        LAS float* PR = (LAS float*)(lds + 8192);
        for (int pc = blockIdx.x; pc < 256; pc += G) {
            const int kv = pc >> 7, row0 = (pc & 127) * 8;
            const float* w2 = kv ? P.cmp_w2_v : P.cmp_w2_k;
            float wv[32];
#pragma unroll
            for (int j = 0; j < 32; ++j) wv[j] = w2[(32 * wave + j) * 64 + lane];
            { const int r = tid >> 6, k4 = (tid & 63) * 4;
              const float* part = (const float*)(ws + WS_PARTH) + (size_t)kv * 8 * 1024 * 256 + (size_t)(row0 + r) * 256 + k4;
              f32x4 a = *(const f32x4*)((const float*)(ws + WS_B1) + kv * 256 + k4);
              a += *(const f32x4*)part;
#pragma unroll
              for (int j = 0; j < 4; ++j) HL[r * 256 + k4 + j] = gelu_tanh(a[j]); }
            __syncthreads();
#pragma unroll
            for (int r = 0; r < 8; ++r) { float acc = 0.f;
#pragma unroll
                for (int j4 = 0; j4 < 8; ++j4) { const f32x4 h = *(const LAS f32x4*)(HL + r * 256 + 32 * wave + 4 * j4);
                    acc += h[0] * wv[4 * j4]; acc += h[1] * wv[4 * j4 + 1]; acc += h[2] * wv[4 * j4 + 2]; acc += h[3] * wv[4 * j4 + 3]; }
                PR[(wave * 8 + r) * 64 + lane] = acc; }
            __syncthreads();
            { const int r = tid >> 6, col = tid & 63, row = row0 + r;
              float sacc = 0.f;
              if ((row & 511) != 511) {
#pragma unroll
                  for (int w = 0; w < 8; ++w) sacc += PR[(w * 8 + r) * 64 + col]; }
              ((bf16_t*)(ws + (kv ? WS_VC : WS_KC)))[(size_t)row * 64 + col] = (bf16_t)(pk2(sacc, 0.f) & 0xffffu); }
            __syncthreads();
        }
        asm volatile("s_waitcnt vmcnt(0)" ::: "memory");
        __syncthreads();
        if (tid == 0) { __builtin_amdgcn_fence(__ATOMIC_RELEASE, "agent"); asm volatile("s_waitcnt vmcnt(0)" ::: "memory");
            __hip_atomic_fetch_add((unsigned*)(ws + WS_CTL) + 320, 1u, __ATOMIC_RELAXED, __HIP_MEMORY_SCOPE_AGENT); }
    }
    STAMP(4);
    {
        unsigned* ctr = (unsigned*)(ws + WS_CTL);
        LAS int* ubox = (LAS int*)(lds + LDS_BYTES - 16);
        for (;;) {
            if (tid == 0) *ubox = (int)atomicAdd(ctr, 1u);
            __syncthreads();
            const int u = __builtin_amdgcn_readfirstlane(*ubox);
            __syncthreads();
            if (u >= g_mla_table.n + CONV_UNITS) break;
            if (u < 4 * CONV_UNITS && (u & 3) == 3) { conv_unit(P, lds, u >> 2); continue; }
            const int mi = u < 4 * CONV_UNITS ? u - ((u + 1) >> 2) : u - CONV_UNITS;
            const int uu = g_mla_table.u[mi];
            mla_unit(P, lds, uu & 15, uu >> 8, (uu >> 4) & 15);
        }
#ifdef PROBE
        if (tid == 0) atomicMax(&TS[5], (unsigned long long)__builtin_amdgcn_s_memrealtime());
#endif
        if (tid == 0) { unsigned sp = 0;
            while (__hip_atomic_load((unsigned*)(ws + WS_CTL) + 320, __ATOMIC_RELAXED, __HIP_MEMORY_SCOPE_AGENT) < (unsigned)G) { __builtin_amdgcn_s_sleep(4); if (++sp > (1u << 22)) break; }
            __builtin_amdgcn_fence(__ATOMIC_ACQUIRE, "agent"); asm volatile("s_waitcnt vmcnt(0)" ::: "memory"); }
        __syncthreads();
        for (;;) {
            if (tid == 0) *ubox = (int)atomicAdd(ctr + 64, 1u);
            __syncthreads();
            const int v = __builtin_amdgcn_readfirstlane(*ubox);
            __syncthreads();
            if (v >= 512) break;
            nsa_unit(P, lds, 255 - (v >> 1), v & 1);
        }
    }
    xcd_barrier(bar); STAMP(6);
    {
        const float* SSQN = (const float*)(ws + WS_SSQN); bf16_t* Y = (bf16_t*)(ws + WS_XN);
#pragma unroll 4
        for (int row = blockIdx.x * 8 + wave; row < T; row += G * 8) {
            const int qb = row >> 8, nch = mla_nch(qb), rl = row & 255;
            float y[16];
            if (nch == 1) {
                const u32x4 w0 = *((const u32x4*)(Y + (size_t)row * DM) + 2 * lane), w1 = *((const u32x4*)(Y + (size_t)row * DM) + 2 * lane + 1);
#pragma unroll
                for (int e = 0; e < 4; ++e) { y[2 * e] = __uint_as_float(w0[e] << 16); y[2 * e + 1] = __uint_as_float(w0[e] & 0xffff0000u);
                                              y[8 + 2 * e] = __uint_as_float(w1[e] << 16); y[8 + 2 * e + 1] = __uint_as_float(w1[e] & 0xffff0000u); }
            } else {
                const int h = lane >> 3, dv = 16 * (lane & 7);
                float mm[3], ll[3]; float mx = NEGBIG;
#pragma unroll
                for (int c = 0; c < 3; ++c) if (c < nch) {
                    const unsigned char* pp = (const unsigned char*)P.out + (size_t)((mla_pbase(qb) + c) * 8 + h) * MLA_PART_BYTES;
                    const f32x2 ml = *(const f32x2*)(pp + 256 * 128 * 2 + rl * 8); mm[c] = ml[0]; ll[c] = ml[1]; mx = fmaxf(mx, ml[0]); } else { mm[c] = NEGBIG; ll[c] = 0.f; }
                float lsum = 0.f;
#pragma unroll
                for (int e = 0; e < 16; ++e) y[e] = 0.f;
#pragma unroll
                for (int c = 0; c < 3; ++c) if (c < nch) {
                    const unsigned char* pp = (const unsigned char*)P.out + (size_t)((mla_pbase(qb) + c) * 8 + h) * MLA_PART_BYTES;
                    const float w = __builtin_amdgcn_exp2f(mm[c] - mx); lsum += w * ll[c];
                    const u32x4* po = (const u32x4*)(pp + ((size_t)rl * 128 + dv) * 2);
#pragma unroll
                    for (int e = 0; e < 2; ++e) { const u32x4 v = po[e];
#pragma unroll
                        for (int k = 0; k < 4; ++k) { y[8 * e + 2 * k] += w * __uint_as_float(v[k] << 16); y[8 * e + 2 * k + 1] += w * __uint_as_float(v[k] & 0xffff0000u); } } }
                const float il = 1.f / lsum;
#pragma unroll
                for (int e = 0; e < 16; ++e) y[e] *= il;
            }
            float ss = 0.f;
#pragma unroll
            for (int e = 0; e < 16; ++e) ss += y[e] * y[e];
            const f32x2 cn = *(const f32x2*)(SSQN + (size_t)row * 2);
            const float rm = rsqrtf(wave_sum(ss) * (1.f / 1024.f) + EPS) * sqrtf((cn[0] + cn[1]) * (1.f / 1024.f) + EPS);
            u32x4 w0, w1;
#pragma unroll
            for (int e = 0; e < 4; ++e) { w0[e] = pk2(y[2 * e] * rm, y[2 * e + 1] * rm); w1[e] = pk2(y[8 + 2 * e] * rm, y[8 + 2 * e + 1] * rm); }
            *((u32x4*)(Y + (size_t)row * DM) + 2 * lane) = w0; *((u32x4*)(Y + (size_t)row * DM) + 2 * lane + 1) = w1;
        }
    }
    xcd_barrier(bar); STAMP(7);
    {
        pg8::Gemm g{(const bf16_t*)(ws + WS_XN), (const bf16_t*)(ws + WS_WO), DM, DM, DM};
        pg8::Order S; S.init(T / 256, DM / 256, G, blockIdx.x);
        EpiO E{0, P.x, P.out, (float*)(ws + WS_SSQ2), (bf16_t*)(ws + WS_HB), (const float*)(ws + WS_SSQN)};
        pg8::gemm_phase(lds, g, S, E);
    }
    xcd_barrier(bar); STAMP(8);
    {
        pg8::Gemm g{(const bf16_t*)(ws + WS_HB), (const bf16_t*)(ws + WS_WUP), DM, DM, DM};
        pg8::Order S; S.init(T / 256, MLPH / 256, G, blockIdx.x);
        LAS float* R2T = (LAS float*)(lds + 131072);
        if (tid < 256) { const int row = (blockIdx.x & 31) * 256 + tid; R2T[tid] = rsqrtf(sum32((const float*)(ws + WS_SSQ2) + (size_t)row * 32) * (1.f / 2048.f) + EPS); }
        __syncthreads();
        EpiUp E{0, R2T, (bf16_t*)(ws + WS_U)};
        pg8::gemm_phase(lds, g, S, E);
    }
    xcd_barrier(bar); STAMP(9);
    if (G == (T / 256) * (DM / 256)) {
        pg8::Gemm g{(const bf16_t*)(ws + WS_U), (const bf16_t*)(ws + WS_WDN), MLPH, MLPH, MLPH};
        pg8::Order S; S.init(T / 256, DM / 256, G, blockIdx.x);
        EpiDownNorm E{0, (const bf16_t*)(ws + WS_HB), P.out, (float*)(ws + WS_SSQ3), (unsigned*)(ws + WS_CTL) + 2048, P.final_norm_w, (LAS float*)(lds + 131072)};
        pg8::gemm_phase(lds, g, S, E);
        STAMP(10);
    } else {
        {
            pg8::Gemm g{(const bf16_t*)(ws + WS_U), (const bf16_t*)(ws + WS_WDN), MLPH, MLPH, MLPH};
            pg8::Order S; S.init(T / 256, DM / 256, G, blockIdx.x);
            EpiDown E{0, (const bf16_t*)(ws + WS_HB), P.out, (float*)(ws + WS_SSQ3)};
            pg8::gemm_phase(lds, g, S, E);
        }
        xcd_barrier(bar);
        const float* SSQ3 = (const float*)(ws + WS_SSQ3);
        for (int row = blockIdx.x * 8 + wave; row < T; row += G * 8) {
            const float r = rsqrtf(sum32(SSQ3 + (size_t)row * 32) * (1.f / DM) + EPS);
            f32x4* o = (f32x4*)(P.out + (size_t)row * DM) + lane;
#pragma unroll
            for (int j = 0; j < 8; ++j) { const f32x4 w = *((const f32x4*)P.final_norm_w + lane + 64 * j); o[64 * j] = o[64 * j] * r * w; }
        }
    }
#ifdef PROBE
    xcd_barrier(bar); STAMP(11);
    if (blockIdx.x == 0) {
        __syncthreads();
        const float a = (float)(TS[PROBE_A + 1] - TS[PROBE_A]) * 0.01f, b = (float)(TS[PROBE_B + 1] - TS[PROBE_B]) * 0.01f;
        if (tid == 0) P.out[2000000] += a * 0.05f;
        for (int i = tid; i < 1000000; i += 512) P.out[i] += b * 0.0005f;
    }
#endif
}

extern "C" void kernel_launch(void* const* d_in, const int* in_sizes, int n_in, void* d_out, int out_size, void* d_ws, size_t ws_size, hipStream_t stream) {
    static int grid = 0;
    if (grid == 0) {
        if (n_in != 21 || out_size != T * DM || ws_size < WS_END) { fprintf(stderr, "kernel_launch: unexpected shapes (n_in %d out %d ws %zu)\n", n_in, out_size, ws_size); grid = -1; return; }
        int dev = 0, cus = 0, per_cu = 0;
        hipGetDevice(&dev);
        hipDeviceGetAttribute(&cus, hipDeviceAttributeMultiprocessorCount, dev);
        hipFuncSetAttribute((const void*)mega_fwd, hipFuncAttributeMaxDynamicSharedMemorySize, LDS_BYTES);
        hipOccupancyMaxActiveBlocksPerMultiprocessor(&per_cu, (const void*)mega_fwd, 512, LDS_BYTES);
        if (per_cu < 1) { fprintf(stderr, "kernel_launch: occupancy query reports %d blocks per CU\n", per_cu); per_cu = 1; }
        (void)hipGetLastError();
        grid = cus;
        if (grid != 256) { fprintf(stderr, "kernel_launch: built for 256 CUs (one workgroup per CU), device reports %d\n", grid); grid = -1; return; }
    }
    if (grid < 0) return;
    hipMemsetAsync((char*)d_ws + WS_CTL, 0, 65536, stream);
    Params p{};
    p.x = (const float*)d_in[0]; p.positions = (const int*)d_in[1]; p.attn_norm_w = (const float*)d_in[2]; p.w_in = (const float*)d_in[3];
    p.mla_q_norm_w = (const float*)d_in[4]; p.mla_w_uq = (const float*)d_in[5]; p.mla_kv_norm_w = (const float*)d_in[6]; p.mla_w_ukv = (const float*)d_in[7];
    p.cmp_pos_k = (const float*)d_in[8]; p.cmp_pos_v = (const float*)d_in[9]; p.cmp_w1_k = (const float*)d_in[10]; p.cmp_w2_k = (const float*)d_in[11];
    p.cmp_w1_v = (const float*)d_in[12]; p.cmp_w2_v = (const float*)d_in[13]; p.mla_out_norm_w = (const float*)d_in[14]; p.nsa_out_norm_w = (const float*)d_in[15];
    p.w_o = (const float*)d_in[16]; p.mlp_norm_w = (const float*)d_in[17]; p.w_up = (const float*)d_in[18]; p.w_down = (const float*)d_in[19]; p.final_norm_w = (const float*)d_in[20];
    p.out = (float*)d_out; p.ws = (unsigned char*)d_ws;
    void* args[] = {&p};
    hipError_t e = hipLaunchCooperativeKernel((const void*)mega_fwd, dim3(grid), dim3(512), args, LDS_BYTES, stream);
    if (e != hipSuccess) fprintf(stderr, "cooperative launch failed: %s (grid %d)\n", hipGetErrorString(e), grid);
}
```

```cpp
#include <hip/hip_runtime.h>
#include <hip/hip_cooperative_groups.h>
#include <cstdio>
#include <cstdint>
namespace cg = cooperative_groups;

#define DI __device__ __forceinline__
#define LAS __attribute__((address_space(3)))
typedef unsigned short bf16_t;
typedef short bf16x8 __attribute__((ext_vector_type(8)));
typedef short s16x4 __attribute__((ext_vector_type(4)));
typedef float f32x4 __attribute__((ext_vector_type(4)));
typedef float f32x16 __attribute__((ext_vector_type(16)));
typedef float f32x2 __attribute__((ext_vector_type(2)));
typedef unsigned u32x4 __attribute__((ext_vector_type(4)));
typedef unsigned u32x2 __attribute__((ext_vector_type(2)));
typedef __bf16 bf16x2_t __attribute__((ext_vector_type(2)));

constexpr int T = 8192, DM = 2048, INW = 2672, INWP = 2816, MLPH = 8192;
constexpr int MH = 8, QRANK = 512, KVRANK = 256, DQK = 192, MDV = 128;
constexpr int NG = 2, NHG = 8, NDK = 64;
constexpr float EPS = 1e-6f, LOG2E = 1.4426950408889634f;
constexpr float QS_MLA = 0.07216878364870322f * LOG2E;
constexpr float QS_NSA = 0.125f * LOG2E;
constexpr float NEGBIG = -1e30f;

constexpr size_t MiB = 1u << 20;
constexpr size_t WS_WDN = 0, WS_WUP = 32 * MiB, WS_WO = 64 * MiB, WS_WIN = 72 * MiB, WS_WUQ = 83 * MiB, WS_WUKV = 84 * MiB + 512 * 1024,
                 WS_W1K = 85 * MiB + 512 * 1024, WS_W1V = 86 * MiB + 512 * 1024;
constexpr size_t WS_XN = 88 * MiB;
constexpr size_t WS_CQ = 120 * MiB, WS_CKV = 128 * MiB, WS_KR = 132 * MiB, WS_QN = 134 * MiB, WS_KVC = 150 * MiB, WS_KVS = 154 * MiB,
                 WS_KVW = 158 * MiB, WS_GATE = 162 * MiB;
constexpr size_t WS_QM = 164 * MiB, WS_KM = 188 * MiB, WS_VM = 212 * MiB, WS_HIDK = 228 * MiB, WS_HIDV = 228 * MiB + 512 * 1024,
                 WS_KC = 229 * MiB, WS_VC = 229 * MiB + 128 * 1024;
constexpr size_t WS_U = 88 * MiB, WS_HB = 216 * MiB;
constexpr size_t WS_PARTH = 230 * MiB;
constexpr size_t WS_CTL = 248 * MiB, WS_COS = 249 * MiB, WS_SIN = 250 * MiB, WS_B1 = 251 * MiB, WS_SSQ2 = 252 * MiB, WS_SSQ3 = 253 * MiB,
                 WS_SSQQ = 254 * MiB, WS_SSQKV = 254 * MiB + 256 * 1024, WS_SSQM = 254 * MiB + 512 * 1024, WS_SSQN = 254 * MiB + 768 * 1024;
constexpr size_t WS_END = 256 * MiB;

constexpr int LDS_BYTES = 147456;

DI unsigned pk2(float lo, float hi) { f32x2 v = {lo, hi}; bf16x2_t b = __builtin_convertvector(v, bf16x2_t); return __builtin_bit_cast(unsigned, b); }
DI float bf2f(bf16_t b) { return __uint_as_float(((unsigned)b) << 16); }
DI u32x2 pk4(f32x4 v) { u32x2 r; r.x = pk2(v[0], v[1]); r.y = pk2(v[2], v[3]); return r; }
DI float max_halves(float x) { const auto r = __builtin_amdgcn_permlane32_swap(__float_as_uint(x), __float_as_uint(x), false, false); float m; asm("v_max_f32 %0, %1, %2" : "=v"(m) : "v"(r[0]), "v"(r[1])); return m; }
DI float sum_halves(float x) { const auto r = __builtin_amdgcn_permlane32_swap(__float_as_uint(x), __float_as_uint(x), false, false); return __uint_as_float(r[0]) + __uint_as_float(r[1]); }
template <int CTRL> DI float dpp_f(float x) { return __int_as_float(__builtin_amdgcn_update_dpp(0, __float_as_int(x), CTRL, 0xf, 0xf, true)); }
DI float sum8(float x) { x += dpp_f<0xB1>(x); x += dpp_f<0x4E>(x); x += dpp_f<0x141>(x); return x; }
DI float wave_sum(float v) {
#pragma unroll
    for (int o = 1; o < 64; o <<= 1) v += __shfl_xor(v, o);
    return v;
}

namespace pg8 {
constexpr int BM = 256, BK = 64, HALF = 128, HTB = HALF * BK * 2, STAGE_BYTES = 8 * HTB;
DI int lds_byte(int r, int c) { const int st = (r >> 4) * 2 + (c >> 5), rr = r & 15, cc = c & 31, ob = rr * 64 + cc * 2; return st * 1024 + (ob ^ (((ob >> 9) & 1) << 5)); }
DI void stage_rc(int b, int& R, int& C) { const int st = b / 1024, sb = b % 1024, swz = sb ^ (((sb >> 9) & 1) << 5); R = (st >> 1) * 16 + swz / 64; C = (st & 1) * 32 + (swz % 64) / 2; }
DI int perm32(int rho) { const int n = rho >> 4, i = rho & 15; return 8 * (i >> 2) + 4 * n + (i & 3); }
struct Unit { int pm, pn, ko; };
struct Gemm { const bf16_t* A; const bf16_t* Bt; int lda, ldb, K; };

struct Order2 {
    int nM, ntot, G, c, kh;
    DI void init(int nM_, int nN_, int G_, int c_, int kh_) { nM = nM_; ntot = nM_ * nN_; G = G_; c = c_; kh = kh_; }
    DI bool next(int i, Unit& u) const { const int L = (i >> 1) * G + c; if (L >= ntot) return false; u.pm = L % nM; u.pn = L / nM; u.ko = (i & 1) * kh; return true; }
    DI void done(const Unit&) const {}
};
struct OrderCmp {
    int G, c;
    DI bool next(int i, Unit& u) const { const int L = i * G + c; if (L >= 32) return false; u.pm = L & 3; u.pn = 0; u.ko = (L >> 2) * 256; return true; }
    DI void done(const Unit&) const {}
};
struct OneUnit { Unit u0; DI bool next(int i, Unit& u) const { if (i) return false; u = u0; return true; } DI void done(const Unit&) const {} };
struct OrderP1 {
    int c; unsigned* cnt; unsigned* pcnt;
    DI bool next(int i, Unit& u) const { u.ko = 0; u.pm = c & 31;
        if (i == 0) { const int k = c >> 5; u.pn = k < 4 ? k : k + 3; return true; }
        if (i == 1 && c < 96) { u.pn = 4 + (c >> 5); return true; }
        return false; }
    DI void done(const Unit& u) const {
        if (u.pn >= 4 && u.pn <= 6) return;
        asm volatile("s_waitcnt vmcnt(0)" ::: "memory");
        __syncthreads();
        if (threadIdx.x == 0) { __builtin_amdgcn_fence(__ATOMIC_RELEASE, "agent"); asm volatile("s_waitcnt vmcnt(0)" ::: "memory");
            const int kind = u.pn <= 1 ? 0 : (u.pn == 2 ? 1 : (u.pn == 3 ? 2 : (u.pn <= 8 ? 3 : -1)));
            if (kind >= 0) __hip_atomic_fetch_add(pcnt + (kind * 32 + u.pm) * 4, 1u, __ATOMIC_RELAXED, __HIP_MEMORY_SCOPE_AGENT);
            __hip_atomic_fetch_add(cnt, 1u, __ATOMIC_RELAXED, __HIP_MEMORY_SCOPE_AGENT); }
    }
};
struct Order {
    int nM, ntot, G, c;
    DI void init(int nM_, int nN_, int G_, int c_) { nM = nM_; ntot = nM_ * nN_; G = G_; c = c_; }
    DI bool next(int i, Unit& u) const { const int L = i * G + c; if (L >= ntot) return false; u.pm = L % nM; u.pn = L / nM; u.ko = 0; return true; }
    DI void done(const Unit&) const {}
};

template <class Epi, class Sched>
DI void gemm_phase(LAS unsigned char* lds, const Gemm g, const Sched& S, const Epi& E) {
    int tid_ = threadIdx.x; asm volatile("" : "+v"(tid_));
    const int tid = tid_, wid = __builtin_amdgcn_readfirstlane(tid >> 6), lane = tid & 63, wr = wid >> 2, wc = wid & 3, fr = lane & 15, fq = lane >> 4;
    const int K = g.K, nt = K / BK;
    unsigned voffA[2], voffB[2];
#pragma unroll
    for (int i = 0; i < 2; ++i) { int R, C; stage_rc(tid * 16 + i * 8192, R, C);
        const int Rb = Epi::PERM ? ((R & ~31) + perm32(R & 31)) : R;
        voffA[i] = (unsigned)(R * g.lda + C) * 2u; voffB[i] = (unsigned)(Rb * g.ldb + C) * 2u; }
    const size_t kstep = (size_t)(BK * 2);
    const size_t hstepA = (size_t)HALF * g.lda * 2, hstepB = (size_t)HALF * g.ldb * 2;
    const size_t tstepA = 2 * hstepA, tstepB = 2 * hstepB;
    const unsigned ldsw = (unsigned)wid * 1024u;
    const int aoff = lds_byte(wr * 64 + fr, fq * 8), boff = lds_byte(wc * 32 + fr, fq * 8);
#define PG8_SA(b, h) (((b) * 2 + (h)) * HTB)
#define PG8_SB(b, h) ((4 + (b) * 2 + (h)) * HTB)
#define PG8_STAGE(bufoff, gbase, voff) do { _Pragma("unroll") for (int _i = 0; _i < 2; ++_i) \
        __builtin_amdgcn_global_load_lds((const unsigned*)((const char*)(gbase) + (voff)[_i]), (LAS unsigned*)(lds + (bufoff) + ldsw + _i * 8192), 16, 0, 0); } while (0)
#define PG8_LDA(dst, b, h) do { _Pragma("unroll") for (int m = 0; m < 4; ++m) _Pragma("unroll") for (int k = 0; k < 2; ++k) dst[m][k] = *(const LAS bf16x8*)(lds + PG8_SA(b, h) + aoff + m * 2048 + k * 1024); } while (0)
#define PG8_LDB(dst, b, h) do { _Pragma("unroll") for (int n = 0; n < 2; ++n) _Pragma("unroll") for (int k = 0; k < 2; ++k) dst[n][k] = *(const LAS bf16x8*)(lds + PG8_SB(b, h) + boff + n * 2048 + k * 1024); } while (0)
#define PG8_MMA(ai, bj, At, Bt) do { __builtin_amdgcn_s_setprio(1); _Pragma("unroll") for (int m = 0; m < 4; ++m) _Pragma("unroll") for (int n = 0; n < 2; ++n) _Pragma("unroll") for (int k = 0; k < 2; ++k) \
        acc[ai][bj][m][n] = __builtin_amdgcn_mfma_f32_16x16x32_bf16(Bt[n][k], At[m][k], acc[ai][bj][m][n], 0, 0, 0); __builtin_amdgcn_s_setprio(0); } while (0)
#define PG8_WAIT_V(n) asm volatile("s_waitcnt vmcnt(" #n ")" ::: "memory")
#define PG8_WAIT_L(n) asm volatile("s_waitcnt lgkmcnt(" #n ")" ::: "memory")
#define PG8_BAR __builtin_amdgcn_s_barrier()
#define PG8_SCHED __builtin_amdgcn_sched_barrier(0)
    Unit cur, nxt; int ui = 0;
    if (!S.next(0, cur)) return;
    f32x4 acc[2][2][4][2];
#pragma unroll
    for (int a = 0; a < 2; ++a)
#pragma unroll
        for (int b = 0; b < 2; ++b)
#pragma unroll
            for (int m = 0; m < 4; ++m)
#pragma unroll
                for (int n = 0; n < 2; ++n) acc[a][b][m][n] = (f32x4){0.f, 0.f, 0.f, 0.f};
    bf16x8 At[4][2], B0[2][2], B1[2][2];
    const char* cA = (const char*)g.A + (size_t)cur.pm * tstepA + (size_t)cur.ko * 2; const char* cB = (const char*)g.Bt + (size_t)cur.pn * tstepB + (size_t)cur.ko * 2;
    PG8_STAGE(PG8_SB(0, 0), cB, voffB); PG8_STAGE(PG8_SB(0, 1), cB + hstepB, voffB); PG8_STAGE(PG8_SA(0, 0), cA, voffA); PG8_STAGE(PG8_SA(0, 1), cA + hstepA, voffA);
    if (wr == 1) PG8_BAR;
    PG8_WAIT_V(2); PG8_BAR;
    PG8_STAGE(PG8_SB(1, 0), cB + kstep, voffB); PG8_STAGE(PG8_SA(1, 0), cA + kstep, voffA); PG8_STAGE(PG8_SB(1, 1), cB + hstepB + kstep, voffB);
    PG8_WAIT_V(6); PG8_BAR;
    for (;;) {
        const bool has_next = S.next(ui + 1, nxt);
        const char* nA = has_next ? (const char*)g.A + (size_t)nxt.pm * tstepA + (size_t)nxt.ko * 2 : cA; const char* nB = has_next ? (const char*)g.Bt + (size_t)nxt.pn * tstepB + (size_t)nxt.ko * 2 : cB;
#pragma clang loop unroll(disable)
        for (int t = 0; t < nt; t += 2) {
            const bool last = (t == nt - 2);
            const char* a1 = cA + (size_t)(t + 1) * kstep;
            const char* a2 = last ? nA : cA + (size_t)(t + 2) * kstep; const char* b2 = last ? nB : cB + (size_t)(t + 2) * kstep;
            const char* a3 = a2 + kstep; const char* b3 = b2 + kstep;
            PG8_LDB(B0, 0, 0); PG8_LDB(B1, 0, 1); PG8_SCHED; PG8_LDA(At, 0, 0); PG8_STAGE(PG8_SA(1, 1), a1 + hstepA, voffA);
            PG8_WAIT_V(8); PG8_WAIT_L(0); PG8_BAR; PG8_MMA(0, 0, At, B0); PG8_MMA(0, 1, At, B1); PG8_BAR; PG8_SCHED;
            PG8_LDA(At, 0, 1); PG8_STAGE(PG8_SB(0, 0), b2, voffB); PG8_STAGE(PG8_SB(0, 1), b2 + hstepB, voffB); PG8_STAGE(PG8_SA(0, 0), a2, voffA);
            PG8_WAIT_V(8); PG8_WAIT_L(0); PG8_BAR; PG8_MMA(1, 0, At, B0); PG8_MMA(1, 1, At, B1); PG8_BAR; PG8_SCHED;
            PG8_LDB(B0, 1, 0); PG8_LDB(B1, 1, 1); PG8_SCHED; PG8_LDA(At, 1, 0); PG8_STAGE(PG8_SA(0, 1), a2 + hstepA, voffA);
            PG8_WAIT_V(8); PG8_WAIT_L(0); PG8_BAR; PG8_MMA(0, 0, At, B0); PG8_MMA(0, 1, At, B1); PG8_BAR; PG8_SCHED;
            PG8_LDA(At, 1, 1); PG8_STAGE(PG8_SB(1, 0), b3, voffB); PG8_STAGE(PG8_SB(1, 1), b3 + hstepB, voffB); PG8_STAGE(PG8_SA(1, 0), a3, voffA);
            PG8_WAIT_V(8); PG8_WAIT_L(0); PG8_BAR; PG8_MMA(1, 0, At, B0); PG8_MMA(1, 1, At, B1); PG8_BAR; PG8_SCHED;
        }
        if (wr == 0) PG8_BAR;
        { Unit ue = cur; asm volatile("" : "+s"(ue.pm), "+s"(ue.pn), "+s"(ue.ko));
          E(acc, ue, wr, wc, fr, fq); }
        S.done(cur);
        if (!has_next) break;
#pragma unroll
        for (int a = 0; a < 2; ++a)
#pragma unroll
            for (int b = 0; b < 2; ++b)
#pragma unroll
                for (int m = 0; m < 4; ++m)
#pragma unroll
                    for (int n = 0; n < 2; ++n) acc[a][b][m][n] = (f32x4){0.f, 0.f, 0.f, 0.f};
        cur = nxt; cA = nA; cB = nB; ++ui;
        if (wr == 1) PG8_BAR;
    }
    PG8_WAIT_V(0);
    PG8_BAR;
#undef PG8_SA
#undef PG8_SB
#undef PG8_STAGE
#undef PG8_LDA
#undef PG8_LDB
#undef PG8_MMA
#undef PG8_WAIT_V
#undef PG8_WAIT_L
#undef PG8_BAR
#undef PG8_SCHED
}
}
using pg8::Unit;

#define EPI_ROWS(ri, row) _Pragma("unroll") for (int ai = 0; ai < 2; ++ai) _Pragma("unroll") for (int m = 0; m < 4; ++m) { const int ri = ai * 4 + m; const int row = u.pm * 256 + ai * 128 + wr * 64 + m * 16 + fr;
#define EPI_COLS(col, v) _Pragma("unroll") for (int bj = 0; bj < 2; ++bj) _Pragma("unroll") for (int n = 0; n < 2; ++n) { const int col = u.pn * 256 + bj * 128 + wc * 32 + n * 16 + fq * 4; f32x4& v = acc[ai][bj][m][n];
#define EPI_END }
typedef f32x4 Acc[2][2][4][2];

DI float dot4(f32x4 v) { return (v[0] * v[0] + v[1] * v[1]) + (v[2] * v[2] + v[3] * v[3]); }

#define EPI_COLS8(col, v0, v1) _Pragma("unroll") for (int bj = 0; bj < 2; ++bj) { const int col = u.pn * 256 + bj * 128 + wc * 32 + fq * 8; f32x4& v0 = acc[ai][bj][m][0]; f32x4& v1 = acc[ai][bj][m][1];
DI u32x4 pk8(f32x4 a, f32x4 b) { u32x4 w; w.x = pk2(a[0], a[1]); w.y = pk2(a[2], a[3]); w.z = pk2(b[0], b[1]); w.w = pk2(b[2], b[3]); return w; }
DI float sigm(float v) { return 1.f / (1.f + __expf(-v)); }
struct EpiIn {
    static constexpr bool HAS_MID = false, PERM = true; int tmid;
    bf16_t *CQ, *CKV, *QN, *KVC, *KVS, *KVW; float *KR, *GATE, *SSQQ, *SSQKV;
    DI void mid(Acc&, const Unit&, int, int, int, int) const {}
    DI void operator()(Acc& acc, const Unit& u, int wr, int wc, int fr, int fq) const {
#pragma unroll
        for (int bj = 0; bj < 2; ++bj) {
            const int cb = __builtin_amdgcn_readfirstlane(u.pn * 256 + bj * 128 + wc * 32), col = cb + fq * 8;
            if (cb < 512) {
                EPI_ROWS(ri, row) *(u32x4*)(CQ + (size_t)row * 512 + col) = pk8(acc[ai][bj][m][0], acc[ai][bj][m][1]); EPI_END
            } else if (cb < 768) {
                EPI_ROWS(ri, row) *(u32x4*)(CKV + (size_t)row * 256 + (col - 512)) = pk8(acc[ai][bj][m][0], acc[ai][bj][m][1]); EPI_END
            } else if (cb < 832) {
                EPI_ROWS(ri, row) float* kr = KR + (size_t)row * 64 + (col - 768); *(f32x4*)kr = acc[ai][bj][m][0]; *(f32x4*)(kr + 4) = acc[ai][bj][m][1]; EPI_END
            } else if (cb < 1856) {
                EPI_ROWS(ri, row) *(u32x4*)(QN + (size_t)row * 1024 + (col - 832)) = pk8(acc[ai][bj][m][0] * QS_NSA, acc[ai][bj][m][1] * QS_NSA); EPI_END
            } else if (cb < 2624) { const int cc = col - 1856, kind = cc >> 8, c2 = cc & 255, g = c2 >> 7, d = c2 & 127, isv = d >> 6;
                bf16_t* kb = KVC + (size_t)kind * (4 * MiB / 2) + (size_t)(isv * 2 + g) * T * 64 + (d & 63);
                EPI_ROWS(ri, row) *(u32x4*)(kb + (size_t)row * 64) = pk8(acc[ai][bj][m][0], acc[ai][bj][m][1]); EPI_END
            } else if (cb < 2688) {
                if (col < 2672) {
                    EPI_ROWS(ri, row) float* gp = GATE + (size_t)row * 48 + (col - 2624); const f32x4 v0 = acc[ai][bj][m][0], v1 = acc[ai][bj][m][1];
                        *(f32x4*)gp = (f32x4){sigm(v0[0]), sigm(v0[1]), sigm(v0[2]), sigm(v0[3])}; *(f32x4*)(gp + 4) = (f32x4){sigm(v1[0]), sigm(v1[1]), sigm(v1[2]), sigm(v1[3])}; EPI_END }
            }
        }
        if (u.pn <= 2) {
            EPI_ROWS(ri, row)
                float s = (dot4(acc[ai][0][m][0]) + dot4(acc[ai][0][m][1])) + (dot4(acc[ai][1][m][0]) + dot4(acc[ai][1][m][1]));
                s += __shfl_xor(s, 16); s += __shfl_xor(s, 32);
                if (fq == 0) { if (u.pn < 2) SSQQ[(size_t)row * 8 + u.pn * 4 + wc] = s; else SSQKV[(size_t)row * 4 + wc] = s; }
            EPI_END
        }
    }
};
struct EpiQ {
    static constexpr bool HAS_MID = false, PERM = true; int tmid;
    bf16_t* QM; const float *SSQQ, *COS, *SIN;
    DI void mid(Acc&, const Unit&, int, int, int, int) const {}
    DI void operator()(Acc& acc, const Unit& u, int wr, int wc, int fr, int fq) const {
        EPI_ROWS(ri, row)
            const f32x4 a = *(const f32x4*)(SSQQ + (size_t)row * 8), b = *(const f32x4*)(SSQQ + (size_t)row * 8 + 4);
            const float r = rsqrtf(((a[0] + a[1]) + (a[2] + a[3]) + (b[0] + b[1]) + (b[2] + b[3])) * (1.f / 512.f) + EPS);
            EPI_COLS8(col, v0, v1)
                const int h = col / 192, p = col - h * 192;
                f32x4 x0 = v0 * r, x1 = v1 * r;
                if (p >= 128) { const int i = (p - 128) >> 1;
                    const f32x4 c = *(const f32x4*)(COS + (size_t)row * 32 + i), sn = *(const f32x4*)(SIN + (size_t)row * 32 + i);
                    f32x4 o0, o1;
                    o0[0] = x0[0] * c[0] - x0[1] * sn[0]; o0[1] = x0[1] * c[0] + x0[0] * sn[0]; o0[2] = x0[2] * c[1] - x0[3] * sn[1]; o0[3] = x0[3] * c[1] + x0[2] * sn[1];
                    o1[0] = x1[0] * c[2] - x1[1] * sn[2]; o1[1] = x1[1] * c[2] + x1[0] * sn[2]; o1[2] = x1[2] * c[3] - x1[3] * sn[3]; o1[3] = x1[3] * c[3] + x1[2] * sn[3];
                    x0 = o0; x1 = o1; }
                *(u32x4*)(QM + (size_t)row * 1536 + col) = pk8(x0 * QS_MLA, x1 * QS_MLA);
            EPI_END
        EPI_END
    }
};
struct EpiKV {
    static constexpr bool HAS_MID = false, PERM = true; int tmid;
    bf16_t *KM, *VM; const float* SSQKV;
    DI void mid(Acc&, const Unit&, int, int, int, int) const {}
    DI void operator()(Acc& acc, const Unit& u, int wr, int wc, int fr, int fq) const {
        EPI_ROWS(ri, row)
            const f32x4 a = *(const f32x4*)(SSQKV + (size_t)row * 4);
            const float r = rsqrtf(((a[0] + a[1]) + (a[2] + a[3])) * (1.f / 256.f) + EPS);
            EPI_COLS8(col, v0, v1)
                const int h = col >> 8, d = col & 255;
                const u32x4 w = pk8(v0 * r, v1 * r);
                if (d < 128) *(u32x4*)(KM + (size_t)row * 1536 + h * 192 + d) = w;
                else *(u32x4*)(VM + (size_t)row * 1024 + h * 128 + (d - 128)) = w;
            EPI_END
        EPI_END
    }
};
DI float gelu_tanh(float x) { const float z = 0.7978845608028654f * (x + 0.044715f * x * x * x); const float e = __expf(2.f * z); const float th = 1.f - 2.f / (e + 1.f); return 0.5f * x * (1.f + th); }
struct EpiPart {
    static constexpr bool HAS_MID = false, PERM = true; int tmid;
    float* PART;
    DI void mid(Acc&, const Unit&, int, int, int, int) const {}
    DI void operator()(Acc& acc, const Unit& u, int wr, int wc, int fr, int fq) const {
        float* base = PART + (size_t)(u.ko >> 8) * 1024 * 256;
        EPI_ROWS(ri, row)
            EPI_COLS8(col, v0, v1) float* pp = base + (size_t)row * 256 + col; *(f32x4*)pp = v0; *(f32x4*)(pp + 4) = v1; EPI_END
        EPI_END
    }
};
struct EpiO {
    static constexpr bool HAS_MID = false, PERM = true; int tmid;
    const float* X; float *H, *SSQ2; bf16_t* HB; const float* SSQN;
    DI void mid(Acc&, const Unit&, int, int, int, int) const {}
    DI void operator()(Acc& acc, const Unit& u, int wr, int wc, int fr, int fq) const {
        EPI_ROWS(ri, row)
            float ss = 0.f;
            const f32x2 cn = *(const f32x2*)(SSQN + (size_t)row * 2);
            const float rn = rsqrtf((cn[0] + cn[1]) * (1.f / 1024.f) + EPS);
            EPI_COLS8(col, v0, v1)
                const float* xp = X + (size_t)row * DM + col;
                const f32x4 h0 = *(const f32x4*)xp + v0 * rn, h1 = *(const f32x4*)(xp + 4) + v1 * rn;
                *(u32x4*)(HB + (size_t)row * DM + col) = pk8(h0, h1); ss += dot4(h0) + dot4(h1);
            EPI_END
            ss += __shfl_xor(ss, 16); ss += __shfl_xor(ss, 32);
            if (fq == 0) SSQ2[(size_t)row * 32 + u.pn * 4 + wc] = ss;
            asm volatile("" ::: "memory");
        EPI_END
    }
};
DI float sum32(const float* p) { float s = 0.f;
#pragma unroll
    for (int j = 0; j < 8; ++j) { const f32x4 a = *(const f32x4*)(p + 4 * j); s += (a[0] + a[1]) + (a[2] + a[3]); }
    return s; }
struct EpiUp {
    static constexpr bool HAS_MID = false, PERM = true; int tmid;
    const LAS float* R2T; bf16_t* U;
    DI void mid(Acc&, const Unit&, int, int, int, int) const {}
    DI void operator()(Acc& acc, const Unit& u, int wr, int wc, int fr, int fq) const {
        EPI_ROWS(ri, row)
            const float r = R2T[row & 255];
#pragma unroll
            for (int bj = 0; bj < 2; ++bj) {
                const int col = u.pn * 256 + bj * 128 + wc * 32 + 8 * fq;
                f32x4 o0, o1;
#pragma unroll
                for (int j = 0; j < 4; ++j) { const float a = fmaxf(acc[ai][bj][m][0][j] * r, 0.f); o0[j] = a * a; const float b = fmaxf(acc[ai][bj][m][1][j] * r, 0.f); o1[j] = b * b; }
                u32x4 w; w.x = pk2(o0[0], o0[1]); w.y = pk2(o0[2], o0[3]); w.z = pk2(o1[0], o1[1]); w.w = pk2(o1[2], o1[3]);
                *(u32x4*)(U + (size_t)row * MLPH + col) = w;
            }
        EPI_END
    }
};
struct EpiDown {
    static constexpr bool HAS_MID = false, PERM = true; int tmid;
    const bf16_t* HB; float *H, *SSQ3;
    DI void mid(Acc&, const Unit&, int, int, int, int) const {}
    DI void operator()(Acc& acc, const Unit& u, int wr, int wc, int fr, int fq) const {
        EPI_ROWS(ri, row)
            float ss = 0.f;
            EPI_COLS8(col, v0, v1)
                const u32x4 hb = *(const u32x4*)(HB + (size_t)row * DM + col);
                const f32x4 o0 = (f32x4){__uint_as_float(hb.x << 16), __uint_as_float(hb.x & 0xffff0000u), __uint_as_float(hb.y << 16), __uint_as_float(hb.y & 0xffff0000u)} + v0;
                const f32x4 o1 = (f32x4){__uint_as_float(hb.z << 16), __uint_as_float(hb.z & 0xffff0000u), __uint_as_float(hb.w << 16), __uint_as_float(hb.w & 0xffff0000u)} + v1;
                float* hp = H + (size_t)row * DM + col; *(f32x4*)hp = o0; *(f32x4*)(hp + 4) = o1; ss += dot4(o0) + dot4(o1);
            EPI_END
            ss += __shfl_xor(ss, 16); ss += __shfl_xor(ss, 32);
            if (fq == 0) SSQ3[(size_t)row * 32 + u.pn * 4 + wc] = ss;
        EPI_END
    }
};
struct EpiDownNorm {
    static constexpr bool HAS_MID = false, PERM = true; int tmid;
    const bf16_t* HB; float* OUT; float* XS; unsigned* CNT; const float* W; LAS float* L;
    DI void mid(Acc&, const Unit&, int, int, int, int) const {}
    DI void operator()(Acc& acc, const Unit& u, int wr, int wc, int fr, int fq) const {
        LAS float* PT = L;
        LAS float* RT = L + 1024;
        EPI_ROWS(ri, row)
            float ss = 0.f;
            EPI_COLS8(col, v0, v1)
                const u32x4 hb = *(const u32x4*)(HB + (size_t)row * DM + col);
                v0[0] += __uint_as_float(hb.x << 16); v0[1] += __uint_as_float(hb.x & 0xffff0000u); v0[2] += __uint_as_float(hb.y << 16); v0[3] += __uint_as_float(hb.y & 0xffff0000u);
                v1[0] += __uint_as_float(hb.z << 16); v1[1] += __uint_as_float(hb.z & 0xffff0000u); v1[2] += __uint_as_float(hb.w << 16); v1[3] += __uint_as_float(hb.w & 0xffff0000u); ss += dot4(v0) + dot4(v1);
            EPI_END
            ss += __shfl_xor(ss, 16); ss += __shfl_xor(ss, 32);
            if (fq == 0) PT[(row & 255) * 4 + wc] = ss;
            asm volatile("" ::: "memory");
        EPI_END
        __syncthreads();
        const int tid = threadIdx.x;
        if (tid < 256) { const f32x4 p = *(const LAS f32x4*)(PT + tid * 4);
            __hip_atomic_store((unsigned*)(XS + (size_t)(u.pm * 256 + tid) * 8 + u.pn), __float_as_uint((p[0] + p[1]) + (p[2] + p[3])), __ATOMIC_RELAXED, __HIP_MEMORY_SCOPE_AGENT); }
        asm volatile("s_waitcnt vmcnt(0)" ::: "memory");
        __syncthreads();
        if (tid == 0) {
            unsigned* c = CNT + 64 * u.pm;
            __hip_atomic_fetch_add(c, 1u, __ATOMIC_RELAXED, __HIP_MEMORY_SCOPE_AGENT);
            unsigned sp = 0;
            while (__hip_atomic_load(c, __ATOMIC_RELAXED, __HIP_MEMORY_SCOPE_AGENT) < 8u) { __builtin_amdgcn_s_sleep(2); if (++sp > (1u << 22)) break; }
            __builtin_amdgcn_fence(__ATOMIC_ACQUIRE, "agent");
            asm volatile("s_waitcnt vmcnt(0)" ::: "memory");
        }
        __syncthreads();
        if (tid < 256) { const float* xs = XS + (size_t)(u.pm * 256 + tid) * 8; float tot = 0.f;
#pragma unroll
            for (int j = 0; j < 8; ++j) tot += __uint_as_float(__hip_atomic_load((const unsigned*)(xs + j), __ATOMIC_RELAXED, __HIP_MEMORY_SCOPE_AGENT));
            RT[tid] = rsqrtf(tot * (1.f / DM) + EPS); }
        __syncthreads();
        EPI_ROWS(ri, row)
            const float r = RT[row & 255];
            EPI_COLS8(col, v0, v1)
                const f32x4 w0 = *(const f32x4*)(W + col), w1 = *(const f32x4*)(W + col + 4);
                float* op = OUT + (size_t)row * DM + col; *(f32x4*)op = v0 * r * w0; *(f32x4*)(op + 4) = v1 * r * w1;
            EPI_END
        EPI_END
    }
};

struct Params {
    const float *x, *attn_norm_w, *w_in, *mla_q_norm_w, *mla_w_uq, *mla_kv_norm_w, *mla_w_ukv, *cmp_pos_k, *cmp_pos_v, *cmp_w1_k, *cmp_w2_k,
        *cmp_w1_v, *cmp_w2_v, *mla_out_norm_w, *nsa_out_norm_w, *w_o, *mlp_norm_w, *w_up, *w_down, *final_norm_w;
    const int* positions;
    float* out; unsigned char* ws;
};

template <class RowMap>
DI void transpose_item(const float* W, int K, int N, bf16_t* WT, const float* kscale, const float* kscale2, int ksplit, LAS float* scr, int item, int lane, RowMap rowmap) {
    const int nblk = (N + 31) / 32, kb = item / nblk, nb = item % nblk, k0 = 64 * kb, n0 = 32 * nb;
    const int nn = n0 + (lane & 31);
    float vals[32];
#pragma unroll
    for (int i = 0; i < 32; ++i) { const int k = k0 + 2 * i + (lane >> 5); vals[i] = nn < N ? __builtin_nontemporal_load(W + (size_t)k * N + nn) : 0.f; }
#pragma unroll
    for (int i = 0; i < 32; ++i) { const int kk = 2 * i + (lane >> 5); const int k = k0 + kk;
        float v = vals[i];
        if (kscale) v *= (k < ksplit ? kscale[k] : kscale2[k - ksplit]);
        scr[kk * 33 + (lane & 31)] = v; }
    asm volatile("s_waitcnt lgkmcnt(0)" ::: "memory");
    const int c = lane & 7;
#pragma unroll
    for (int j = 0; j < 4; ++j) { const int n = (lane >> 3) + 8 * j; const LAS float* s = scr + (8 * c) * 33 + n;
        u32x4 o; o.x = pk2(s[0 * 33], s[1 * 33]); o.y = pk2(s[2 * 33], s[3 * 33]); o.z = pk2(s[4 * 33], s[5 * 33]); o.w = pk2(s[6 * 33], s[7 * 33]);
        if (n0 + n < N) *(u32x4*)(WT + (size_t)rowmap(n0 + n) * K + k0 + 8 * c) = o; }
    asm volatile("s_waitcnt lgkmcnt(0)" ::: "memory");
}
struct RowId { DI int operator()(int n) const { return n; } };
struct RowUq { DI int operator()(int n) const { const int h = n / 192, d = n - h * 192; if (d < 128) return n; const int i = d - 128; return h * 192 + 128 + (i < 32 ? 2 * i : 2 * (i - 32) + 1); } };

DI void sincos_acc(float a, float& sn, float& cs) {
    const double ad = (double)a;
    const double q = __builtin_rint(ad * 0.6366197723675814);
    const double r = (ad - q * 1.5707963267948966) - q * 6.123233995736766e-17;
    const double r2 = r * r;
    const double sp = r * (1.0 + r2 * (-1.0 / 6 + r2 * (1.0 / 120 + r2 * (-1.0 / 5040 + r2 * (1.0 / 362880 + r2 * (-1.0 / 39916800))))));
    const double cp = 1.0 + r2 * (-0.5 + r2 * (1.0 / 24 + r2 * (-1.0 / 720 + r2 * (1.0 / 40320 + r2 * (-1.0 / 3628800 + r2 * (1.0 / 479001600))))));
    const int qi = ((int)q) & 3;
    const double s = (qi == 0) ? sp : (qi == 1) ? cp : (qi == 2) ? -sp : -cp;
    const double c = (qi == 0) ? cp : (qi == 1) ? -sp : (qi == 2) ? -cp : sp;
    sn = (float)s; cs = (float)c;
}

DI void p0_prep(const Params& P, LAS unsigned char* lds, int G) {
    const int tid = threadIdx.x, lane = tid & 63, wave = __builtin_amdgcn_readfirstlane(tid >> 6);
    LAS float* scr = (LAS float*)(lds + wave * 16384);
    const int gw = blockIdx.x * 8 + wave, NGW = G * 8;
    unsigned char* ws = P.ws;
    bf16_t* Win_t = (bf16_t*)(ws + WS_WIN); bf16_t* Wuq_t = (bf16_t*)(ws + WS_WUQ); bf16_t* Wukv_t = (bf16_t*)(ws + WS_WUKV);
    bf16_t* W1k_t = (bf16_t*)(ws + WS_W1K); bf16_t* W1v_t = (bf16_t*)(ws + WS_W1V); bf16_t* Wo_t = (bf16_t*)(ws + WS_WO);
    bf16_t* Wup_t = (bf16_t*)(ws + WS_WUP); bf16_t* Wdn_t = (bf16_t*)(ws + WS_WDN);
    constexpr int I_IN = (DM / 64) * ((INW + 31) / 32), I_UQ = (QRANK / 64) * (1536 / 32), I_UKV = (KVRANK / 64) * (2048 / 32), I_W1 = (2048 / 64) * (256 / 32),
                  I_O = (DM / 64) * (DM / 32), I_UP = (DM / 64) * (MLPH / 32), I_DN = (MLPH / 64) * (DM / 32);
    constexpr int NITEMS = I_IN + I_UQ + I_UKV + 2 * I_W1;
    for (int it = gw; it < NITEMS; it += NGW) {
        int r = it;
        if (r < I_IN) { transpose_item(P.w_in, DM, INW, Win_t, nullptr, nullptr, 0, scr, r, lane, RowId()); continue; } r -= I_IN;
        if (r < I_UQ) { transpose_item(P.mla_w_uq, QRANK, 1536, Wuq_t, P.mla_q_norm_w, P.mla_q_norm_w, QRANK, scr, r, lane, RowUq()); continue; } r -= I_UQ;
        if (r < I_UKV) { transpose_item(P.mla_w_ukv, KVRANK, 2048, Wukv_t, P.mla_kv_norm_w, P.mla_kv_norm_w, KVRANK, scr, r, lane, RowId()); continue; } r -= I_UKV;
        if (r < I_W1) { transpose_item(P.cmp_w1_k, 2048, 256, W1k_t, nullptr, nullptr, 0, scr, r, lane, RowId()); continue; } r -= I_W1;
        transpose_item(P.cmp_w1_v, 2048, 256, W1v_t, nullptr, nullptr, 0, scr, r, lane, RowId());
    }
    bf16_t* XN = (bf16_t*)(ws + WS_XN);
    for (int row = gw; row < T; row += 2 * NGW) {
        const int row2 = row + NGW; const bool has2 = row2 < T;
        const f32x4* xa = (const f32x4*)(P.x + (size_t)row * DM) + 2 * lane; const f32x4* xb = (const f32x4*)(P.x + (size_t)(has2 ? row2 : row) * DM) + 2 * lane;
        f32x4 va[8], vb[8]; float sa = 0.f, sb = 0.f;
#pragma unroll
        for (int j = 0; j < 4; ++j) { va[2 * j] = __builtin_nontemporal_load(xa + 128 * j); va[2 * j + 1] = __builtin_nontemporal_load(xa + 128 * j + 1);
                                      vb[2 * j] = __builtin_nontemporal_load(xb + 128 * j); vb[2 * j + 1] = __builtin_nontemporal_load(xb + 128 * j + 1); }
#pragma unroll
        for (int j = 0; j < 8; ++j) { sa += dot4(va[j]); sb += dot4(vb[j]); }
        const float ra = rsqrtf(wave_sum(sa) * (1.f / DM) + EPS), rb = rsqrtf(wave_sum(sb) * (1.f / DM) + EPS);
#pragma unroll
        for (int j = 0; j < 4; ++j) { const f32x4 w0 = *((const f32x4*)P.attn_norm_w + 2 * lane + 128 * j), w1 = *((const f32x4*)P.attn_norm_w + 2 * lane + 128 * j + 1);
            const u32x2 a0 = pk4(va[2 * j] * ra * w0), a1 = pk4(va[2 * j + 1] * ra * w1);
            *(u32x4*)(XN + (size_t)row * DM + (2 * lane + 128 * j) * 4) = (u32x4){a0.x, a0.y, a1.x, a1.y};
            if (has2) { const u32x2 b0 = pk4(vb[2 * j] * rb * w0), b1 = pk4(vb[2 * j + 1] * rb * w1);
                *(u32x4*)(XN + (size_t)row2 * DM + (2 * lane + 128 * j) * 4) = (u32x4){b0.x, b0.y, b1.x, b1.y}; } }
    }
    const int gt = blockIdx.x * 512 + tid, NGT = G * 512;
    for (int i = gt; i < (INWP - INW) * DM / 8; i += NGT) *(u32x4*)(Win_t + (size_t)INW * DM + (size_t)i * 8) = (u32x4){0u, 0u, 0u, 0u};
    float* COS = (float*)(ws + WS_COS); float* SIN = (float*)(ws + WS_SIN);
    { const int j = gt & 31;
      const float ex = (float)(2 * j) / 64.0f;
      const float pw = (float)exp((double)ex * 9.210340371976184);
      const float inv = 1.0f / pw;
      for (int i = gt; i < T * 32; i += NGT) { const int t = i >> 5;
          const float ang = (float)P.positions[t] * inv;
          float sn, cs; sincos_acc(ang, sn, cs); COS[i] = cs; SIN[i] = sn; } }
    { float* PART = (float*)(ws + WS_B1 + 4096); const int kv = tid >> 8, n = tid & 255;
      const float* pos = kv ? P.cmp_pos_v : P.cmp_pos_k; const float* w1 = kv ? P.cmp_w1_v : P.cmp_w1_k;
      float sacc = 0.f;
      for (int k0 = blockIdx.x; k0 < 2048; k0 += 8 * G) {
          float pv[8], wv[8];
#pragma unroll
          for (int e = 0; e < 8; ++e) { const int k = k0 + e * G; const bool ok = k < 2048; pv[e] = ok ? pos[k] : 0.f; wv[e] = ok ? w1[(size_t)k * 256 + n] : 0.f; }
#pragma unroll
          for (int e = 0; e < 8; ++e) sacc += pv[e] * wv[e]; }
      PART[(size_t)blockIdx.x * 512 + tid] = sacc; }
}

constexpr int CONV_UNITS = 128;
DI void conv_unit(const Params& P, LAS unsigned char* lds, int j) {
    int tq = threadIdx.x; asm volatile("" : "+v"(tq));
    const int lane = tq & 63, wave = __builtin_amdgcn_readfirstlane(tq >> 6);
    LAS float* scr = (LAS float*)(lds + wave * 16384);
    bf16_t* Wo_t = (bf16_t*)(P.ws + WS_WO); bf16_t* Wup_t = (bf16_t*)(P.ws + WS_WUP); bf16_t* Wdn_t = (bf16_t*)(P.ws + WS_WDN);
    constexpr int I_O = (DM / 64) * (DM / 32), I_UP = (DM / 64) * (MLPH / 32), I_DN = (MLPH / 64) * (DM / 32), PER = (I_O + I_UP + I_DN) / CONV_UNITS;
    static_assert((I_O + I_UP + I_DN) % CONV_UNITS == 0, "conversion items per unit");
    for (int it = j * PER + wave; it < (j + 1) * PER; it += 8) {
        int r = it;
        if (r < I_O) { transpose_item(P.w_o, DM, DM, Wo_t, P.mla_out_norm_w, P.nsa_out_norm_w, 1024, scr, r, lane, RowId()); continue; } r -= I_O;
        if (r < I_UP) { transpose_item(P.w_up, DM, MLPH, Wup_t, P.mlp_norm_w, P.mlp_norm_w, DM, scr, r, lane, RowId()); continue; } r -= I_UP;
        transpose_item(P.w_down, MLPH, DM, Wdn_t, nullptr, nullptr, 0, scr, r, lane, RowId());
    }
    __syncthreads();
}

DI f32x16 mfma32(bf16x8 a, bf16x8 b, f32x16 c) { return __builtin_amdgcn_mfma_f32_32x32x16_bf16(a, b, c, 0, 0, 0); }
typedef short v4i16_t __attribute__((ext_vector_type(4)));
DI s16x4 vtr(const LAS char* p) { return __builtin_bit_cast(s16x4, __builtin_amdgcn_ds_read_tr16_b64_v4i16((LAS v4i16_t*)p)); }
DI int crow(int r, int hi) { return (r & 3) + 8 * (r >> 2) + 4 * hi; }
#define CR(r) (((r) & 3) + 8 * ((r) >> 2))

template <int NKS, int PKB>
DI void qk_tile(const LAS char* Kt, const bf16x8* qf, int r32, int hi, f32x16& s0, f32x16& s1) {
    const LAS char* kb = Kt + r32 * PKB + hi * 16;
#pragma unroll
    for (int ks = 0; ks < NKS; ++ks) {
        const bf16x8 a0 = *(const LAS bf16x8*)(kb + ks * 32);
        const bf16x8 a1 = *(const LAS bf16x8*)(kb + 32 * PKB + ks * 32);
        s0 = mfma32(a0, qf[ks], s0); s1 = mfma32(a1, qf[ks], s1);
    }
}
template <int ND0, int PVB>
DI void pv_tile(const LAS char* Vt, const f32x16& p0, const f32x16& p1, f32x16* o, int lane) {
    const int hi = lane >> 5, q = (lane & 15) >> 2, p = lane & 3, blk = (lane >> 4) & 1;
    const LAS char* vb = Vt + (4 * hi + q) * PVB + (16 * blk + 4 * p) * 2;
    bf16x8 pa[4];
    { u32x4 w;
      w.x = pk2(p0[0], p0[1]); w.y = pk2(p0[2], p0[3]); w.z = pk2(p0[4], p0[5]); w.w = pk2(p0[6], p0[7]); pa[0] = __builtin_bit_cast(bf16x8, w);
      w.x = pk2(p0[8], p0[9]); w.y = pk2(p0[10], p0[11]); w.z = pk2(p0[12], p0[13]); w.w = pk2(p0[14], p0[15]); pa[1] = __builtin_bit_cast(bf16x8, w);
      w.x = pk2(p1[0], p1[1]); w.y = pk2(p1[2], p1[3]); w.z = pk2(p1[4], p1[5]); w.w = pk2(p1[6], p1[7]); pa[2] = __builtin_bit_cast(bf16x8, w);
      w.x = pk2(p1[8], p1[9]); w.y = pk2(p1[10], p1[11]); w.z = pk2(p1[12], p1[13]); w.w = pk2(p1[14], p1[15]); pa[3] = __builtin_bit_cast(bf16x8, w); }
    s16x4 lo[2][4], hh[2][4];
#pragma unroll
    for (int kk = 0; kk < 4; ++kk) { lo[0][kk] = vtr(vb + (16 * kk) * PVB); hh[0][kk] = vtr(vb + (16 * kk + 8) * PVB); }
#pragma unroll
    for (int d0 = 0; d0 < ND0; ++d0) {
        if (d0 + 1 < ND0) {
#pragma unroll
            for (int kk = 0; kk < 4; ++kk) { lo[(d0 + 1) & 1][kk] = vtr(vb + (16 * kk) * PVB + (d0 + 1) * 64); hh[(d0 + 1) & 1][kk] = vtr(vb + (16 * kk + 8) * PVB + (d0 + 1) * 64); }
        }
#pragma unroll
        for (int kk = 0; kk < 4; ++kk) {
            const s16x4 a = lo[d0 & 1][kk], b = hh[d0 & 1][kk];
            const bf16x8 vf = (bf16x8){a[0], a[1], a[2], a[3], b[0], b[1], b[2], b[3]};
            o[d0] = mfma32(pa[kk], vf, o[d0]);
        }
        __builtin_amdgcn_sched_barrier(0);
    }
}
template <int PKB>
DI void qk_tile4(const LAS char* Kt, const bf16x8* qf, int r32, int hi, f32x16& s0, f32x16& s1) {
    const LAS char* kb = Kt + r32 * PKB + hi * 16;
    bf16x8 a0[4], a1[4];
#pragma unroll
    for (int ks = 0; ks < 4; ++ks) { a0[ks] = *(const LAS bf16x8*)(kb + ks * 32); a1[ks] = *(const LAS bf16x8*)(kb + 32 * PKB + ks * 32); }
    __builtin_amdgcn_sched_barrier(0);
#pragma unroll
    for (int ks = 0; ks < 4; ++ks) { s0 = mfma32(a0[ks], qf[ks], s0); s1 = mfma32(a1[ks], qf[ks], s1); }
}
template <int PVB>
DI void pv_prefetch(const LAS char* Vt, int lane, s16x4* lo0, s16x4* hh0) {
    const int hi = lane >> 5, q = (lane & 15) >> 2, p = lane & 3, blk = (lane >> 4) & 1;
    const LAS char* vb = Vt + (4 * hi + q) * PVB + (16 * blk + 4 * p) * 2;
#pragma unroll
    for (int kk = 0; kk < 4; ++kk) { lo0[kk] = vtr(vb + (16 * kk) * PVB); hh0[kk] = vtr(vb + (16 * kk + 8) * PVB); }
    __builtin_amdgcn_sched_barrier(0);
}
template <int ND0, int PVB>
DI void pv_tile_pf(const LAS char* Vt, const f32x16& p0, const f32x16& p1, f32x16* o, int lane, const s16x4* lo0, const s16x4* hh0) {
    const int hi = lane >> 5, q = (lane & 15) >> 2, p = lane & 3, blk = (lane >> 4) & 1;
    const LAS char* vb = Vt + (4 * hi + q) * PVB + (16 * blk + 4 * p) * 2;
    bf16x8 pa[4];
    { u32x4 w;
      w.x = pk2(p0[0], p0[1]); w.y = pk2(p0[2], p0[3]); w.z = pk2(p0[4], p0[5]); w.w = pk2(p0[6], p0[7]); pa[0] = __builtin_bit_cast(bf16x8, w);
      w.x = pk2(p0[8], p0[9]); w.y = pk2(p0[10], p0[11]); w.z = pk2(p0[12], p0[13]); w.w = pk2(p0[14], p0[15]); pa[1] = __builtin_bit_cast(bf16x8, w);
      w.x = pk2(p1[0], p1[1]); w.y = pk2(p1[2], p1[3]); w.z = pk2(p1[4], p1[5]); w.w = pk2(p1[6], p1[7]); pa[2] = __builtin_bit_cast(bf16x8, w);
      w.x = pk2(p1[8], p1[9]); w.y = pk2(p1[10], p1[11]); w.z = pk2(p1[12], p1[13]); w.w = pk2(p1[14], p1[15]); pa[3] = __builtin_bit_cast(bf16x8, w); }
    s16x4 lo[2][4], hh[2][4];
#pragma unroll
    for (int kk = 0; kk < 4; ++kk) { lo[0][kk] = lo0[kk]; hh[0][kk] = hh0[kk]; }
#pragma unroll
    for (int d0 = 0; d0 < ND0; ++d0) {
        if (d0 + 1 < ND0) {
#pragma unroll
            for (int kk = 0; kk < 4; ++kk) { lo[(d0 + 1) & 1][kk] = vtr(vb + (16 * kk) * PVB + (d0 + 1) * 64); hh[(d0 + 1) & 1][kk] = vtr(vb + (16 * kk + 8) * PVB + (d0 + 1) * 64); }
        }
#pragma unroll
        for (int kk = 0; kk < 4; ++kk) {
            const s16x4 a = lo[d0 & 1][kk], b = hh[d0 & 1][kk];
            const bf16x8 vf = (bf16x8){a[0], a[1], a[2], a[3], b[0], b[1], b[2], b[3]};
            o[d0] = mfma32(pa[kk], vf, o[d0]);
        }
        __builtin_amdgcn_sched_barrier(0);
    }
}
DI float max3(float a, float b, float c) { float r; asm("v_max3_f32 %0, %1, %2, %3" : "=v"(r) : "v"(a), "v"(b), "v"(c)); return r; }
DI float rowmax32(const f32x16& s0, const f32x16& s1) {
    float a[10];
#pragma unroll
    for (int i = 0; i < 5; ++i) { a[i] = max3(s0[3 * i], s0[3 * i + 1], s0[3 * i + 2]); a[5 + i] = max3(s1[3 * i], s1[3 * i + 1], s1[3 * i + 2]); }
    const float b0 = max3(a[0], a[1], a[2]), b1 = max3(a[3], a[4], s0[15]), b2 = max3(a[5], a[6], a[7]), b3 = max3(a[8], a[9], s1[15]);
    return max3(max3(b0, b1, b2), b3, b3);
}
template <int ND0>
DI void online_update(f32x16& s0, f32x16& s1, float& m, float& l, f32x16* o, LAS float* wsf, int r32, int hi) {
    const float mx = max_halves(rowmax32(s0, s1));
    if (__any(mx > m + 8.f)) {
        const float mnew = fmaxf(m, mx);
        const float alpha = __builtin_amdgcn_exp2f(m - mnew);
        if constexpr (ND0 > 0) {
            if (hi == 0) wsf[r32] = alpha;
            asm volatile("s_waitcnt lgkmcnt(0)" ::: "memory");
#pragma unroll
            for (int r = 0; r < 16; ++r) { const float a = wsf[crow(r, hi)];
#pragma unroll
                for (int d = 0; d < ND0; ++d) o[d][r] *= a; }
            asm volatile("s_waitcnt lgkmcnt(0)" ::: "memory");
        }
        l *= alpha; m = mnew;
    }
    const float mref = m;
    float ls[4] = {0.f, 0.f, 0.f, 0.f};
#pragma unroll
    for (int r = 0; r < 16; ++r) { s0[r] = __builtin_amdgcn_exp2f(s0[r] - mref); s1[r] = __builtin_amdgcn_exp2f(s1[r] - mref); ls[r & 3] += s0[r] + s1[r]; }
    l += (ls[0] + ls[1]) + (ls[2] + ls[3]);
}

template <int ND0>
DI void online_update_rel(f32x16& s0, f32x16& s1, f32x16& negm, float& m, float& l, f32x16* o, LAS float* wsf, int r32, int hi, bool first) {
    const float mx = max_halves(rowmax32(s0, s1));
    if (first || __any(mx > 8.f)) {
        const float d = first ? mx : fmaxf(mx, 0.f);
        if (!first) {
            const float alpha = __builtin_amdgcn_exp2f(-d);
            if (hi == 0) wsf[r32] = alpha;
            asm volatile("s_waitcnt lgkmcnt(0)" ::: "memory");
#pragma unroll
            for (int r = 0; r < 16; ++r) { const float a = wsf[crow(r, hi)];
#pragma unroll
                for (int dd = 0; dd < ND0; ++dd) o[dd][r] *= a; }
            asm volatile("s_waitcnt lgkmcnt(0)" ::: "memory");
            l *= alpha;
        }
        m += d;
#pragma unroll
        for (int r = 0; r < 16; ++r) { negm[r] = -m; s0[r] -= d; s1[r] -= d; }
    }
#pragma unroll
    for (int r = 0; r < 16; ++r) { s0[r] = __builtin_amdgcn_exp2f(s0[r]); s1[r] = __builtin_amdgcn_exp2f(s1[r]); }
    float ls[4];
#pragma unroll
    for (int j = 0; j < 4; ++j) ls[j] = s0[j] + s1[j];
#pragma unroll
    for (int r = 4; r < 16; ++r) ls[r & 3] += s0[r] + s1[r];
    l += (ls[0] + ls[1]) + (ls[2] + ls[3]);
}

template <int PKB>
DI void qk_tile12(const LAS char* Kt, const bf16x8* qf, int r32, int hi, f32x16& s0, f32x16& s1) {
    const LAS char* kb = Kt + r32 * PKB + hi * 16;
    bf16x8 a0[2][2], a1[2][2];
#pragma unroll
    for (int j = 0; j < 2; ++j) { a0[0][j] = *(const LAS bf16x8*)(kb + j * 32); a1[0][j] = *(const LAS bf16x8*)(kb + 32 * PKB + j * 32); }
#pragma unroll
    for (int g = 0; g < 6; ++g) {
        if (g + 1 < 6) {
#pragma unroll
            for (int j = 0; j < 2; ++j) { a0[(g + 1) & 1][j] = *(const LAS bf16x8*)(kb + ((g + 1) * 2 + j) * 32); a1[(g + 1) & 1][j] = *(const LAS bf16x8*)(kb + 32 * PKB + ((g + 1) * 2 + j) * 32); }
        }
        __builtin_amdgcn_sched_barrier(0);
#pragma unroll
        for (int j = 0; j < 2; ++j) { s0 = mfma32(a0[g & 1][j], qf[g * 2 + j], s0); s1 = mfma32(a1[g & 1][j], qf[g * 2 + j], s1); }
        __builtin_amdgcn_sched_barrier(0);
    }
}

constexpr int MLA_PK = 400, MLA_PV = 320, MLA_KB = 64 * MLA_PK, MLA_VB = 64 * MLA_PV;
constexpr int MLA_WS = 2 * MLA_KB + 2 * MLA_VB;
constexpr int MLA_CS = 48;
DI constexpr int mla_nch(int qb) { return (4 * qb + 4 + MLA_CS - 1) / MLA_CS; }
DI constexpr int mla_pbase(int qb) { return qb < 12 ? 0 : (qb < 24 ? (qb - 12) * 2 : 24 + (qb - 24) * 3); }
constexpr size_t MLA_PART_BYTES = 256 * 128 * 2 + 256 * 2 * 4;
DI void mla_unit(const Params& P, LAS unsigned char* lds, int h, int qb, int c) {
    int tid_ = threadIdx.x; asm volatile("" : "+v"(tid_));
    const int tid = tid_, lane = tid & 63, wave = __builtin_amdgcn_readfirstlane(tid >> 6), r32 = lane & 31, hi = lane >> 5;
    const bf16_t* QM = (const bf16_t*)(P.ws + WS_QM); const bf16_t* KM = (const bf16_t*)(P.ws + WS_KM); const bf16_t* VM = (const bf16_t*)(P.ws + WS_VM);
    bf16_t* Y = (bf16_t*)(P.ws + WS_XN);
    LAS float* wsf = (LAS float*)(lds + MLA_WS + wave * 256);
    if (wave >= 4) __builtin_amdgcn_s_setprio(1);
    const int q0 = qb * 256 + wave * 32;
    bf16x8 qf[12];
    { const bf16_t* qp = QM + (size_t)(q0 + r32) * 1536 + h * 192 + hi * 8;
#pragma unroll
      for (int ks = 0; ks < 12; ++ks) qf[ks] = *(const bf16x8*)(qp + ks * 16); }
    f32x16 o[4];
#pragma unroll
    for (int d = 0; d < 4; ++d)
#pragma unroll
        for (int r = 0; r < 16; ++r) o[d][r] = 0.f;
    float m = 0.f, l = 0.f;
    f32x16 negm;
#pragma unroll
    for (int r = 0; r < 16; ++r) negm[r] = 0.f;
    const int NT = 4 * qb + 4, nch = mla_nch(qb), per = (NT + nch - 1) / nch;
    const int tb = c * per, te = (tb + per < NT) ? tb + per : NT;
    unsigned kgo[3], vgo[2], klo[3], vlo[2];
    { const int sr = tid >> 3, sc = tid & 7;
#pragma unroll
      for (int i = 0; i < 3; ++i) { kgo[i] = (unsigned)(sr * 1536 + (sc + 8 * i) * 8) * 2u; klo[i] = (unsigned)(sr * MLA_PK + (sc + 8 * i) * 16); }
#pragma unroll
      for (int i = 0; i < 2; ++i) { vgo[i] = (unsigned)(sr * 1024 + (sc + 8 * i) * 8) * 2u; vlo[i] = (unsigned)(2 * MLA_KB + sr * MLA_PV + (sc + 8 * i) * 16); } }
    const char* KMh = (const char*)(KM + h * 192); const char* VMh = (const char*)(VM + h * 128);
    u32x4 kreg[3], vreg[2];
#define MLA_LOAD(t) do { const char* kb_ = KMh + (size_t)(t) * (64 * 1536 * 2); const char* vb_ = VMh + (size_t)(t) * (64 * 1024 * 2); \
                         _Pragma("unroll") for (int i = 0; i < 3; ++i) kreg[i] = *(const u32x4*)(kb_ + kgo[i]); \
                         _Pragma("unroll") for (int i = 0; i < 2; ++i) vreg[i] = *(const u32x4*)(vb_ + vgo[i]); } while (0)
#define MLA_WRITE(b) do { _Pragma("unroll") for (int i = 0; i < 3; ++i) *(LAS u32x4*)(lds + (b) * MLA_KB + klo[i]) = kreg[i]; \
                          _Pragma("unroll") for (int i = 0; i < 2; ++i) *(LAS u32x4*)(lds + (b) * MLA_VB + vlo[i]) = vreg[i]; } while (0)
    MLA_LOAD(tb); MLA_WRITE(tb & 1);
    __builtin_amdgcn_s_waitcnt(0x0F70);
    if (tb + 1 < te) MLA_LOAD(tb + 1);
    __syncthreads();
    for (int t = tb; t < te; ++t) {
        const int b = t & 1;
        if (t + 1 < te) { MLA_WRITE(b ^ 1); if (t + 2 < te) MLA_LOAD(t + 2); }
        const int k0 = t * 64;
        if (k0 <= q0 + 31) {
            f32x16 s0 = negm, s1 = negm;
            qk_tile12<MLA_PK>((const LAS char*)(lds + b * MLA_KB), qf, r32, hi, s0, s1);
            if (k0 + 63 > q0) {
                const int d0 = q0 + r32 - k0 - 4 * hi;
#pragma unroll
                for (int r = 0; r < 16; ++r) { if (CR(r) > d0) s0[r] = NEGBIG; if (CR(r) + 32 > d0) s1[r] = NEGBIG; }
            }
            s16x4 vlo[4], vhh[4]; pv_prefetch<MLA_PV>((const LAS char*)(lds + 2 * MLA_KB + b * MLA_VB), lane, vlo, vhh);
            online_update_rel<4>(s0, s1, negm, m, l, o, wsf, r32, hi, t == tb);
            pv_tile_pf<4, MLA_PV>((const LAS char*)(lds + 2 * MLA_KB + b * MLA_VB), s0, s1, o, lane, vlo, vhh);
        }
        __syncthreads();
    }
#undef MLA_LOAD
#undef MLA_WRITE
    const float lt = sum_halves(l);
    if (nch == 1) {
        if (hi == 0) wsf[r32] = 1.f / lt;
        asm volatile("s_waitcnt lgkmcnt(0)" ::: "memory");
#pragma unroll
        for (int r = 0; r < 16; ++r) {
            const int row = crow(r, hi); const float il = wsf[row];
#pragma unroll
            for (int d = 0; d < 4; ++d) Y[(size_t)(q0 + row) * DM + h * 128 + d * 32 + r32] = (bf16_t)(pk2(o[d][r] * il, 0.f) & 0xffffu);
        }
    } else {
        unsigned char* pp = (unsigned char*)P.out + (size_t)((mla_pbase(qb) + c) * 8 + h) * MLA_PART_BYTES;
        bf16_t* PO = (bf16_t*)pp; float* PML = (float*)(pp + 256 * 128 * 2);
        if (hi == 0) { PML[(wave * 32 + r32) * 2] = m; PML[(wave * 32 + r32) * 2 + 1] = lt; }
#pragma unroll
        for (int r = 0; r < 16; ++r) {
            const int row = wave * 32 + crow(r, hi);
#pragma unroll
            for (int d = 0; d < 4; ++d) PO[(size_t)row * 128 + d * 32 + r32] = (bf16_t)(pk2(o[d][r], 0.f) & 0xffffu);
        }
    }
    __builtin_amdgcn_s_setprio(0);
    __syncthreads();
}
struct MlaTable { unsigned short u[512]; int n; };
constexpr MlaTable make_mla_table() {
    MlaTable t{}; int cost[512] = {}; int n = 0;
    for (int qb = 31; qb >= 0; --qb) { const int NT = 4 * qb + 4, nch = mla_nch(qb), per = (NT + nch - 1) / nch;
        for (int c = 0; c < nch; ++c) { const int tb = c * per, te = (tb + per < NT) ? tb + per : NT;
            for (int h = 0; h < 8; ++h) { t.u[n] = (unsigned short)((qb << 8) | (c << 4) | h); cost[n] = te - tb; ++n; } } }
    for (int i = 1; i < n; ++i) { const unsigned short uu = t.u[i]; const int cc = cost[i]; int j = i - 1;
        while (j >= 0 && cost[j] < cc) { t.u[j + 1] = t.u[j]; cost[j + 1] = cost[j]; --j; }
        t.u[j + 1] = uu; cost[j + 1] = cc; }
    t.n = n; return t;
}
__device__ const MlaTable g_mla_table = make_mla_table();

constexpr int NSA_PK = 144, NSA_PV = 192, NSA_KB = 64 * NSA_PK, NSA_VB = 64 * NSA_PV, NSA_TB = NSA_KB + NSA_VB;
constexpr int NSA_WS = 2 * NSA_TB;
constexpr int NSA_WSZ = 4608 + 8192;
constexpr int NSA_BU = NSA_WS + 8 * NSA_WSZ;

DI void nsa_bias_mfma(f32x16& s0, f32x16& s1, unsigned qbw, unsigned qd2, unsigned qd3, unsigned uk0, unsigned uk1, int base, int hi) {
    const unsigned bb = __float_as_uint((float)base) >> 16;
    const unsigned w1 = hi == 0 ? (bb | (bb << 16)) : 0u, w2 = hi == 0 ? 0x3F803F80u : 0u, w3 = hi == 0 ? 0x3F80u : 0u;
    const u32x4 k0 = {uk0, w1, w2, w3}, k1 = {uk1, w1, w2, w3};
    const bf16x8 qfb = __builtin_bit_cast(bf16x8, ((u32x4){qbw, qbw, qd2, qd3}));
    s0 = mfma32(__builtin_bit_cast(bf16x8, k0), qfb, s0); s1 = mfma32(__builtin_bit_cast(bf16x8, k1), qfb, s1);
}
template <int ND0>
DI void online_update_k(f32x16& s0, f32x16& s1, float& m, unsigned& nh16, unsigned& nl, float& l, f32x16* o, LAS float* wsf, int r32, int hi, bool first) {
    const float mx = max_halves(rowmax32(s0, s1));
    if (first || __any(mx > 8.f)) {
        const float dt = mx > -1e29f ? (first ? mx : fmaxf(mx, 0.f)) : 0.f;
        const float neg = -(m + dt);
        const unsigned hb = pk2(neg, 0.f) & 0xffffu; const float fh = __uint_as_float(hb << 16);
        const unsigned lb = pk2(neg - fh, 0.f) & 0xffffu; const float fl = __uint_as_float(lb << 16);
        const bool ch = dt != 0.f;
        const float mnew = ch ? -(fh + fl) : m;
        const float d = mnew - m;
        if (!first) {
            const float alpha = __builtin_amdgcn_exp2f(-d);
            if constexpr (ND0 > 0) {
                if (hi == 0) wsf[r32] = alpha;
                asm volatile("s_waitcnt lgkmcnt(0)" ::: "memory");
#pragma unroll
                for (int r = 0; r < 16; ++r) { const float a = wsf[crow(r, hi)];
#pragma unroll
                    for (int dd = 0; dd < ND0; ++dd) o[dd][r] *= a; }
                asm volatile("s_waitcnt lgkmcnt(0)" ::: "memory");
            }
            l *= alpha;
        }
        if (ch) { nh16 = hi == 0 ? (hb << 16) : 0u; nl = hi == 0 ? lb : 0u; }
        m = mnew;
#pragma unroll
        for (int r = 0; r < 16; ++r) { s0[r] -= d; s1[r] -= d; }
    }
#pragma unroll
    for (int r = 0; r < 16; ++r) { s0[r] = __builtin_amdgcn_exp2f(s0[r]); s1[r] = __builtin_amdgcn_exp2f(s1[r]); }
    float ls[4];
#pragma unroll
    for (int j = 0; j < 4; ++j) ls[j] = s0[j] + s1[j];
#pragma unroll
    for (int r = 4; r < 16; ++r) ls[r & 3] += s0[r] + s1[r];
    l += (ls[0] + ls[1]) + (ls[2] + ls[3]);
}

DI void nsa_unit(const Params& P, LAS unsigned char* lds, int tile, int g) {
    int tid_ = threadIdx.x; asm volatile("" : "+v"(tid_));
    const int tid = tid_, lane = tid & 63, wave = __builtin_amdgcn_readfirstlane(tid >> 6), r32 = lane & 31, hi = lane >> 5;
    const unsigned char* ws = P.ws;
    const bf16_t* QN = (const bf16_t*)(ws + WS_QN);
    const bf16_t* KC = (const bf16_t*)(ws + WS_KC) + (size_t)g * 512 * 64; const bf16_t* VC = (const bf16_t*)(ws + WS_VC) + (size_t)g * 512 * 64;
    const bf16_t* KS = (const bf16_t*)(ws + WS_KVS) + (size_t)g * T * 64; const bf16_t* VS = (const bf16_t*)(ws + WS_KVS) + (size_t)(2 + g) * T * 64;
    const bf16_t* KW = (const bf16_t*)(ws + WS_KVW) + (size_t)g * T * 64; const bf16_t* VW = (const bf16_t*)(ws + WS_KVW) + (size_t)(2 + g) * T * 64;
    const float* GATE = (const float*)(ws + WS_GATE);
    bf16_t* Y = (bf16_t*)(P.ws + WS_XN); float* SSQN = (float*)(P.ws + WS_SSQN);
    LAS unsigned char* wsb = lds + NSA_WS + wave * NSA_WSZ;
    LAS float* wsf = (LAS float*)wsb; LAS unsigned* selm = (LAS unsigned*)(wsb + 128); LAS float* AE = (LAS float*)(wsb + 512);
    LAS unsigned* BU = (LAS unsigned*)(lds + NSA_BU);

    const int t0 = tile * 32, cur = t0 >> 6;
    const int tokl = r32 >> 3, head = r32 & 7, hidx = g * 8 + head;
    const int t = t0 + wave * 4 + tokl;
    const float sl2 = __builtin_amdgcn_exp2f(-0.5f * (float)(hidx + 1)) * LOG2E;
    const unsigned slh = pk2(sl2, 0.f) & 0xffffu; const unsigned sll = pk2(sl2 - __uint_as_float(slh << 16), 0.f) & 0xffffu;
    const unsigned qbw = hi == 0 ? (slh | (sll << 16)) : 0u;
    const unsigned qmask = hi == 0 ? 0xF14Au : 0u;
    const unsigned uks0 = hi == 0 ? pk2((float)r32, (float)r32) : 0u, uks1 = hi == 0 ? pk2((float)(r32 + 32), (float)(r32 + 32)) : 0u;
    const unsigned ukc0 = hi == 0 ? pk2((float)(16 * r32), (float)(16 * r32)) : 0u, ukc1 = hi == 0 ? pk2((float)(16 * r32 + 512), (float)(16 * r32 + 512)) : 0u;
    bf16x8 qf[4];
    { const bf16_t* qp = QN + (size_t)t * 1024 + hidx * 64 + hi * 8;
#pragma unroll
      for (int ks = 0; ks < 4; ++ks) qf[ks] = *(const bf16x8*)(qp + ks * 16); }
    if (tid < 4) BU[tid] = 0u;
    LAS float* yl = (LAS float*)(wsb + 4608) + lane;
    const float gc = GATE[(size_t)t * 48 + hidx * 3 + 0], gs = GATE[(size_t)t * 48 + hidx * 3 + 1], gw = GATE[(size_t)t * 48 + hidx * 3 + 2];

    const int srow = tid >> 3, sch = tid & 7, soff = srow * 64 + sch * 8;
    u32x4 kreg, vreg; int par = 0;
#define NSA_LDK(base) kreg = *(const u32x4*)((base) + soff)
#define NSA_LDV(base) vreg = *(const u32x4*)((base) + soff)
#define NSA_WRK() *(LAS u32x4*)(lds + par * NSA_TB + srow * NSA_PK + sch * 16) = kreg
#define NSA_WRV() *(LAS u32x4*)(lds + par * NSA_TB + NSA_KB + srow * NSA_PV + sch * 16) = vreg
#define NSA_KT ((const LAS char*)(lds + par * NSA_TB))
#define NSA_VT ((const LAS char*)(lds + par * NSA_TB + NSA_KB))

    const int ntc = ((t0 >> 4) + 1 + 63) >> 6;
    float mc = 0.f, lc = 0.f; unsigned nh16 = 0u, nl = 0u;
    NSA_LDK(KC);
    for (int i = 0; i < ntc; ++i) {
        const int n0 = 64 * i;
        NSA_WRK();
        __syncthreads();
        if (i + 1 < ntc) NSA_LDK(KC + (size_t)(n0 + 64) * 64); else { NSA_LDK(KC); NSA_LDV(VC); }
        f32x16 s0, s1;
#pragma unroll
        for (int r = 0; r < 16; ++r) { s0[r] = 0.f; s1[r] = 0.f; }
        qk_tile4<NSA_PK>(NSA_KT, qf, r32, hi, s0, s1);
        const int db = t - 31 - 16 * (n0 + 4 * hi);
        nsa_bias_mfma(s0, s1, qbw, nh16, nl, ukc0, ukc1, 1024 * (i - (ntc - 1)), hi);
        if (16 * (n0 + 63) + 31 > t0) {
#pragma unroll
            for (int r = 0; r < 16; ++r) { if (16 * CR(r) > db) s0[r] = NEGBIG; if (16 * CR(r) + 512 > db) s1[r] = NEGBIG; }
        }
        online_update_k<0>(s0, s1, mc, nh16, nl, lc, nullptr, wsf, r32, hi, i == 0);
        par ^= 1;
    }
    const float lct = sum_halves(lc);
    const float ilc = (t >= 31) ? 1.f / lct : 0.f;
    f32x16 oc[2];
#pragma unroll
    for (int d = 0; d < 2; ++d)
#pragma unroll
        for (int r = 0; r < 16; ++r) oc[d][r] = 0.f;
    for (int i = 0; i < ntc; ++i) {
        const int n0 = 64 * i;
        NSA_WRK(); NSA_WRV();
        __syncthreads();
        if (i + 1 < ntc) { NSA_LDK(KC + (size_t)(n0 + 64) * 64); NSA_LDV(VC + (size_t)(n0 + 64) * 64); }
        else { NSA_LDK(KS + (size_t)cur * 64 * 64); NSA_LDV(VS + (size_t)cur * 64 * 64); }
        f32x16 s0, s1;
#pragma unroll
        for (int r = 0; r < 16; ++r) { s0[r] = 0.f; s1[r] = 0.f; }
        qk_tile4<NSA_PK>(NSA_KT, qf, r32, hi, s0, s1);
        const int db = t - 31 - 16 * (n0 + 4 * hi);
        nsa_bias_mfma(s0, s1, qbw, nh16, nl, ukc0, ukc1, 1024 * (i - (ntc - 1)), hi);
        s16x4 vlo[4], vhh[4]; pv_prefetch<NSA_PV>(NSA_VT, lane, vlo, vhh);
        if (16 * (n0 + 63) + 31 > t0) {
#pragma unroll
            for (int r = 0; r < 16; ++r) { if (16 * CR(r) > db) s0[r] = NEGBIG; if (16 * CR(r) + 512 > db) s1[r] = NEGBIG; }
        }
#pragma unroll
        for (int r = 0; r < 16; ++r) { s0[r] = __builtin_amdgcn_exp2f(s0[r]) * ilc; s1[r] = __builtin_amdgcn_exp2f(s1[r]) * ilc; }
        { float av[8], ev[8];
#pragma unroll
          for (int kh = 0; kh < 2; ++kh)
#pragma unroll
              for (int qd = 0; qd < 4; ++qd) { const f32x16& s = kh ? s1 : s0;
                  av[kh * 4 + qd] = (s[4 * qd] + s[4 * qd + 1]) + (s[4 * qd + 2] + s[4 * qd + 3]); ev[kh * 4 + qd] = s[4 * qd + 3]; }
#pragma unroll
          for (int k = 0; k < 8; ++k) { av[k] = dpp_f<0xB1>(av[k]) + av[k]; ev[k] = dpp_f<0xB1>(ev[k]) + ev[k]; }
#pragma unroll
          for (int k = 0; k < 8; ++k) { av[k] = dpp_f<0x4E>(av[k]) + av[k]; ev[k] = dpp_f<0x4E>(ev[k]) + ev[k]; }
#pragma unroll
          for (int k = 0; k < 8; ++k) { av[k] = dpp_f<0x141>(av[k]) + av[k]; ev[k] = dpp_f<0x141>(ev[k]) + ev[k]; }
          if (head == 0) {
#pragma unroll
              for (int kh = 0; kh < 2; ++kh)
#pragma unroll
                  for (int qd = 0; qd < 4; ++qd) { const int blk = 16 * i + 8 * kh + 2 * qd + hi; AE[tokl * 128 + blk] = av[kh * 4 + qd]; AE[512 + tokl * 128 + blk] = ev[kh * 4 + qd]; }
          } }
        pv_tile_pf<2, NSA_PV>(NSA_VT, s0, s1, oc, lane, vlo, vhh);
        par ^= 1;
    }
    if (hi == 0) wsf[r32] = gc;
    asm volatile("s_waitcnt lgkmcnt(0)" ::: "memory");
#pragma unroll
    for (int r = 0; r < 16; ++r) { const float a = wsf[crow(r, hi)]; yl[r * 64] = oc[0][r] * a; yl[(16 + r) * 64] = oc[1][r] * a; }
    asm volatile("s_waitcnt lgkmcnt(0)" ::: "memory");

    unsigned wu0 = 0u, wu1 = 0u, wu2 = 0u, wu3 = 0u;
    if (cur < 16) {
        wu0 = (2u << cur) - 1u;
        if (lane < 16) selm[lane] = (lane & 3) == 0 ? wu0 : 0u;
    } else {
        unsigned f0 = 1u, f1 = 0u, f2 = 0u, f3 = 0u;
        { const int b = cur; if (b < 32) f0 |= 1u << b; else if (b < 64) f1 |= 1u << (b - 32); else if (b < 96) f2 |= 1u << (b - 64); else f3 |= 1u << (b - 96); }
        { const int b = cur - 1; if (b < 32) f0 |= 1u << b; else if (b < 64) f1 |= 1u << (b - 32); else if (b < 96) f2 |= 1u << (b - 64); else f3 |= 1u << (b - 96); }
        unsigned key0[4], key1[4];
#pragma unroll
        for (int tk = 0; tk < 4; ++tk) {
            key0[tk] = 0u; key1[tk] = 0u;
            { const int sb = lane; if (sb >= 1 && sb <= cur - 2) key0[tk] = __float_as_uint(AE[tk * 128 + sb] + AE[512 + tk * 128 + sb - 1]); }
            { const int sb = lane + 64; if (sb <= cur - 2) key1[tk] = __float_as_uint(AE[tk * 128 + sb] + AE[512 + tk * 128 + sb - 1]); }
        }
        const unsigned long long val0 = __ballot(lane >= 1 && lane <= cur - 2), val1 = __ballot(lane + 64 <= cur - 2);
        unsigned thr[4] = {0u, 0u, 0u, 0u};
        if (cur - 2 >= 64) {
#pragma unroll 1
        for (int bit = 30; bit >= 0; --bit) {
#pragma unroll
            for (int tk = 0; tk < 4; ++tk) {
                const unsigned cand = thr[tk] | (1u << bit);
                unsigned long long b0, b1;
                asm("v_cmp_le_u32_e64 %0, %1, %2" : "=s"(b0) : "s"(cand), "v"(key0[tk]));
                asm("v_cmp_le_u32_e64 %0, %1, %2" : "=s"(b1) : "s"(cand), "v"(key1[tk]));
                const int cnt = __popcll(b0) + __popcll(b1);
                if (cnt >= 13) thr[tk] = cand;
            }
        }
        } else {
#pragma unroll 1
        for (int bit = 30; bit >= 0; --bit) {
#pragma unroll
            for (int tk = 0; tk < 4; ++tk) {
                const unsigned cand = thr[tk] | (1u << bit);
                unsigned long long b0;
                asm("v_cmp_le_u32_e64 %0, %1, %2" : "=s"(b0) : "s"(cand), "v"(key0[tk]));
                const int cnt = __popcll(b0);
                if (cnt >= 13) thr[tk] = cand;
            }
        }
        }
#pragma unroll
        for (int tk = 0; tk < 4; ++tk) {
            unsigned long long g0 = __ballot(key0[tk] > thr[tk]) & val0, g1 = __ballot(key1[tk] > thr[tk]) & val1;
            unsigned long long e0 = __ballot(key0[tk] == thr[tk]) & val0, e1 = __ballot(key1[tk] == thr[tk]) & val1;
            int need = 13 - (__popcll(g0) + __popcll(g1));
#pragma unroll 1
            for (; need > 0; --need) { if (e0) { const unsigned long long bq = e0 & (0ull - e0); g0 |= bq; e0 ^= bq; } else { const unsigned long long bq = e1 & (0ull - e1); g1 |= bq; e1 ^= bq; } }
            const unsigned mk0 = __builtin_amdgcn_readfirstlane(f0 | (unsigned)g0), mk1 = __builtin_amdgcn_readfirstlane(f1 | (unsigned)(g0 >> 32)),
                           mk2 = __builtin_amdgcn_readfirstlane(f2 | (unsigned)g1), mk3 = __builtin_amdgcn_readfirstlane(f3 | (unsigned)(g1 >> 32));
            if (lane == 0) { selm[tk * 4 + 0] = mk0; selm[tk * 4 + 1] = mk1; selm[tk * 4 + 2] = mk2; selm[tk * 4 + 3] = mk3; }
            wu0 |= mk0; wu1 |= mk1; wu2 |= mk2; wu3 |= mk3;
        }
    }
    if (lane == 0) { atomicOr((unsigned*)&BU[0], wu0); atomicOr((unsigned*)&BU[1], wu1); atomicOr((unsigned*)&BU[2], wu2); atomicOr((unsigned*)&BU[3], wu3); }
    asm volatile("s_waitcnt lgkmcnt(0)" ::: "memory");
    const unsigned ms0 = selm[tokl * 4 + 0], ms1 = selm[tokl * 4 + 1], ms2 = selm[tokl * 4 + 2], ms3 = selm[tokl * 4 + 3];
    __syncthreads();
    unsigned bu[4]; bu[0] = __builtin_amdgcn_readfirstlane(BU[0]); bu[1] = __builtin_amdgcn_readfirstlane(BU[1]); bu[2] = __builtin_amdgcn_readfirstlane(BU[2]); bu[3] = __builtin_amdgcn_readfirstlane(BU[3]);

    {
        f32x16 o[2];
#pragma unroll
        for (int d = 0; d < 2; ++d)
#pragma unroll
            for (int r = 0; r < 16; ++r) o[d][r] = 0.f;
        float m = 0.f, l = 0.f; nh16 = 0u; nl = 0u; bool first = true;
        if (cur < 32) bu[0] &= ~(1u << cur); else if (cur < 64) bu[1] &= ~(1u << (cur - 32)); else if (cur < 96) bu[2] &= ~(1u << (cur - 64)); else bu[3] &= ~(1u << (cur - 96));
#define NSA_NEXT(nb) do { nb = -1; \
            if (bu[3]) nb = 127 - __builtin_clz(bu[3]); else if (bu[2]) nb = 95 - __builtin_clz(bu[2]); else if (bu[1]) nb = 63 - __builtin_clz(bu[1]); else if (bu[0]) nb = 31 - __builtin_clz(bu[0]); \
            if (nb >= 0) { if (nb < 32) bu[0] &= ~(1u << nb); else if (nb < 64) bu[1] &= ~(1u << (nb - 32)); else if (nb < 96) bu[2] &= ~(1u << (nb - 64)); else bu[3] &= ~(1u << (nb - 96)); } } while (0)
#define NSA_SEL_COMPUTE(b) do { \
            const unsigned wuw = b < 32 ? wu0 : (b < 64 ? wu1 : (b < 96 ? wu2 : wu3)); \
            if ((wuw >> (b & 31)) & 1u) { \
                const unsigned msw = b < 32 ? ms0 : (b < 64 ? ms1 : (b < 96 ? ms2 : ms3)); \
                const bool selme = (msw >> (b & 31)) & 1u; \
                f32x16 s0, s1; \
                _Pragma("unroll") for (int r = 0; r < 16; ++r) { s0[r] = 0.f; s1[r] = 0.f; } \
                qk_tile4<NSA_PK>(NSA_KT, qf, r32, hi, s0, s1); \
                const int db = t - 64 * b - 4 * hi;            \
                nsa_bias_mfma(s0, s1, qbw, (selme ? 0u : qmask) | nh16, nl, uks0, uks1, 64 * (b - cur), hi); \
                s16x4 vlo[4], vhh[4]; pv_prefetch<NSA_PV>(NSA_VT, lane, vlo, vhh); \
                if (b == cur) { \
                    _Pragma("unroll") for (int r = 0; r < 16; ++r) { if (CR(r) > db) s0[r] = NEGBIG; if (CR(r) + 32 > db) s1[r] = NEGBIG; } \
                } \
                online_update_k<2>(s0, s1, m, nh16, nl, l, o, wsf, r32, hi, first); first = false; \
                pv_tile_pf<2, NSA_PV>(NSA_VT, s0, s1, o, lane, vlo, vhh); \
            } } while (0)
        int b = cur;
        for (;;) {
            NSA_WRK(); NSA_WRV();
            __syncthreads();
            int nb; NSA_NEXT(nb);
            if (nb >= 0) { NSA_LDK(KS + (size_t)nb * 64 * 64); NSA_LDV(VS + (size_t)nb * 64 * 64); }
            else { NSA_LDK(KW + (size_t)cur * 64 * 64); NSA_LDV(VW + (size_t)cur * 64 * 64); }
            NSA_SEL_COMPUTE(b);
            par ^= 1;
            if (nb < 0) break;
            b = nb;
        }
#undef NSA_NEXT
#undef NSA_SEL_COMPUTE
        const float lt = sum_halves(l);
        if (hi == 0) wsf[r32] = gs / lt;
        asm volatile("s_waitcnt lgkmcnt(0)" ::: "memory");
#pragma unroll
        for (int r = 0; r < 16; ++r) { const float a = wsf[crow(r, hi)]; yl[r * 64] += o[0][r] * a; yl[(16 + r) * 64] += o[1][r] * a; }
        asm volatile("s_waitcnt lgkmcnt(0)" ::: "memory");
    }
    {
        f32x16 o[2];
#pragma unroll
        for (int d = 0; d < 2; ++d)
#pragma unroll
            for (int r = 0; r < 16; ++r) o[d][r] = 0.f;
        float m = 0.f, l = 0.f; nh16 = 0u; nl = 0u;
        const int ktlo = (t0 - 511) > 0 ? ((t0 - 511) >> 6) : 0;
        for (int kt = cur; kt >= ktlo; --kt) {
            NSA_WRK(); NSA_WRV();
            __syncthreads();
            if (kt > ktlo) { NSA_LDK(KW + (size_t)(kt - 1) * 64 * 64); NSA_LDV(VW + (size_t)(kt - 1) * 64 * 64); }
            f32x16 s0, s1;
#pragma unroll
            for (int r = 0; r < 16; ++r) { s0[r] = 0.f; s1[r] = 0.f; }
            qk_tile4<NSA_PK>(NSA_KT, qf, r32, hi, s0, s1);
            const int db = t - 64 * kt - 4 * hi;
            nsa_bias_mfma(s0, s1, qbw, nh16, nl, uks0, uks1, 64 * (kt - cur), hi);
            s16x4 vlo[4], vhh[4]; pv_prefetch<NSA_PV>(NSA_VT, lane, vlo, vhh);
            if (kt == cur) {
#pragma unroll
                for (int r = 0; r < 16; ++r) { if (CR(r) > db) s0[r] = NEGBIG; if (CR(r) + 32 > db) s1[r] = NEGBIG; }
            }
            if (t0 + 31 - 64 * kt >= 512) {
#pragma unroll
                for (int r = 0; r < 16; ++r) { if (db - CR(r) >= 512) s0[r] = NEGBIG; if (db - 32 - CR(r) >= 512) s1[r] = NEGBIG; }
            }
            online_update_k<2>(s0, s1, m, nh16, nl, l, o, wsf, r32, hi, kt == cur);
            pv_tile_pf<2, NSA_PV>(NSA_VT, s0, s1, o, lane, vlo, vhh);
            par ^= 1;
        }
        const float lt = sum_halves(l);
        if (hi == 0) wsf[r32] = gw / lt;
        asm volatile("s_waitcnt lgkmcnt(0)" ::: "memory");
#pragma unroll
        for (int r = 0; r < 16; ++r) { const float a = wsf[crow(r, hi)]; yl[r * 64] += o[0][r] * a; yl[(16 + r) * 64] += o[1][r] * a; }
        asm volatile("s_waitcnt lgkmcnt(0)" ::: "memory");
    }
#undef NSA_LDK
#undef NSA_LDV
#undef NSA_WRK
#undef NSA_WRV
#undef NSA_KT
#undef NSA_VT
    float ssq[4];
#pragma unroll
    for (int tk = 0; tk < 4; ++tk) ssq[tk] = 0.f;
#pragma unroll
    for (int r = 0; r < 16; ++r) {
        const int tk = r >> 2, hd = (r & 3) + 4 * hi;
#pragma unroll
        for (int d = 0; d < 2; ++d) { const float y = yl[(d * 16 + r) * 64]; ssq[tk] += y * y;
            Y[(size_t)(t0 + wave * 4 + tk) * DM + 1024 + (g * 8 + hd) * 64 + d * 32 + r32] = (bf16_t)(pk2(y, 0.f) & 0xffffu); }
    }
#pragma unroll
    for (int tk = 0; tk < 4; ++tk) { const float s = wave_sum(ssq[tk]); if (lane == 0) SSQN[(size_t)(t0 + wave * 4 + tk) * 2 + g] = s; }
    __syncthreads();
}

#define XB_TMO      128
#define XB_XCNT(j)  (256  + 64 * (j))
#define XB_XSUB(j)  (1280 + 64 * (j))
#define XB_XGEN(j)  (2304 + 64 * (j))
#define XB_TOP      3328
#define XB_TOPGEN   3392
#define XCD_BAR_WORDS 3456
#define XB_SPIN_CAP (1u << 18)
DI unsigned xb_ld(unsigned* p)              { return __hip_atomic_load(p, __ATOMIC_RELAXED, __HIP_MEMORY_SCOPE_AGENT); }
DI unsigned xb_add(unsigned* p, unsigned v) { return __hip_atomic_fetch_add(p, v, __ATOMIC_RELAXED, __HIP_MEMORY_SCOPE_AGENT); }
DI unsigned xb_xcc_id() { return (unsigned)__builtin_amdgcn_s_getreg((3 << 11) | 20) & 0xFu; }
#define XB_SPIN(cond, bar) do { unsigned _sp = 0; while (cond) { __builtin_amdgcn_s_sleep(1); \
    if ((++_sp & 255u) == 0u) { if (xb_ld(&(bar)[XB_TMO])) break; if (_sp > XB_SPIN_CAP) { atomicAdd(&(bar)[XB_TMO], 1u); break; } } } } while (0)
struct XcdBarrier { unsigned* bar; unsigned x; volatile LAS unsigned* st; };
DI XcdBarrier xcd_barrier_post(unsigned* bar, volatile LAS unsigned* st) {
    XcdBarrier b; b.bar = bar; b.x = xb_xcc_id(); b.st = st;
    if (threadIdx.x == 0) (void)xb_add(&bar[XB_XCNT(b.x)], 1u);
    return b;
}
DI void xcd_barrier_complete(unsigned* bar, unsigned x, unsigned& nloc, unsigned& nx) {
    const unsigned G = gridDim.x * gridDim.y * gridDim.z;
    unsigned sum, cnt, mine, sp = 0u;
    for (;;) {
        sum = 0u; cnt = 0u; mine = 0u;
#pragma unroll
        for (unsigned j = 0; j < 16; ++j) { const unsigned c = xb_ld(&bar[XB_XCNT(j)]); sum += c; cnt += (c > 0u) ? 1u : 0u; mine = (j == x) ? c : mine; }
        if (sum == G) break;
        __builtin_amdgcn_s_sleep(1);
        if ((++sp & 255u) == 0u) { if (xb_ld(&bar[XB_TMO])) break; if (sp > XB_SPIN_CAP) { atomicAdd(&bar[XB_TMO], 1u); break; } }
    }
    nloc = mine > 0u ? mine : 1u; nx = cnt > 0u ? cnt : 1u;
}
DI void xcd_barrier(const XcdBarrier& b) {
    asm volatile("s_waitcnt vmcnt(0)" ::: "memory");
    __syncthreads();
    if (threadIdx.x == 0) {
        unsigned* bar = b.bar;
        __builtin_amdgcn_s_waitcnt(0);
        unsigned nloc = b.st[0], nx = b.st[1];
        if (nloc == 0u) { xcd_barrier_complete(bar, b.x, nloc, nx); b.st[0] = nloc; b.st[1] = nx; }
        const unsigned old = xb_add(&bar[XB_XSUB(b.x)], 1u);
        const unsigned gen = old / nloc;
        if (old + 1u == (gen + 1u) * nloc) {
            __builtin_amdgcn_fence(__ATOMIC_RELEASE, "agent");
            asm volatile("s_waitcnt vmcnt(0)" ::: "memory");
            const unsigned og = xb_add(&bar[XB_TOP], 1u);
            const unsigned tg = og / nx;
            if (og + 1u == (tg + 1u) * nx) xb_add(&bar[XB_TOPGEN], 1u);
            else XB_SPIN(xb_ld(&bar[XB_TOPGEN]) == tg, bar);
            __builtin_amdgcn_fence(__ATOMIC_ACQUIRE, "agent");
            xb_add(&bar[XB_XGEN(b.x)], 1u);
            asm volatile("s_waitcnt vmcnt(0)" ::: "memory");
        } else {
            XB_SPIN(xb_ld(&bar[XB_XGEN(b.x)]) == gen, bar);
            __builtin_amdgcn_fence(__ATOMIC_ACQUIRE, "agent");
            asm volatile("s_waitcnt vmcnt(0)" ::: "memory");
        }
    }
    __syncthreads();
}

__global__ void __launch_bounds__(512, 2) mega_fwd(Params P) {
    extern __shared__ __attribute__((aligned(16))) unsigned char lds_raw[];
    LAS unsigned char* lds = (LAS unsigned char*)lds_raw;
    const int G = gridDim.x, tid = threadIdx.x, lane = tid & 63, wave = __builtin_amdgcn_readfirstlane(tid >> 6);
    unsigned char* ws = P.ws;
    if (tid < 8) ((LAS unsigned*)(lds + LDS_BYTES - 32))[tid] = 0u;
    __syncthreads();
#ifdef PROBE
    unsigned long long* TS = (unsigned long long*)(ws + WS_CTL + 32768);
#define STAMP(k) do { if (blockIdx.x == 0 && tid == 0) TS[k] = __builtin_amdgcn_s_memrealtime(); } while (0)
#else
#define STAMP(k) do {} while (0)
#endif
    STAMP(0);
    const XcdBarrier bar = xcd_barrier_post((unsigned*)(ws + WS_CTL) + 4096, (volatile LAS unsigned*)(lds + LDS_BYTES - 32));
    p0_prep(P, lds, G);
    xcd_barrier(bar); STAMP(1);
    if (G == 256) {
        if (blockIdx.x == G - 1) { const float* PART = (const float*)(ws + WS_B1 + 4096); float sacc = 0.f;
            for (int b = 0; b < G; ++b) sacc += PART[(size_t)b * 512 + tid];
            ((float*)(ws + WS_B1))[tid] = sacc; }
        unsigned* cnt1 = (unsigned*)(ws + WS_CTL) + 192; unsigned* ctr2 = (unsigned*)(ws + WS_CTL) + 128;
        {
            pg8::Gemm g{(const bf16_t*)(ws + WS_XN), (const bf16_t*)(ws + WS_WIN), DM, DM, DM};
            pg8::OrderP1 S{(int)blockIdx.x, cnt1, (unsigned*)(ws + WS_CTL) + 512};
            EpiIn E{0, (bf16_t*)(ws + WS_CQ), (bf16_t*)(ws + WS_CKV), (bf16_t*)(ws + WS_QN), (bf16_t*)(ws + WS_KVC), (bf16_t*)(ws + WS_KVS), (bf16_t*)(ws + WS_KVW),
                    (float*)(ws + WS_KR), (float*)(ws + WS_GATE), (float*)(ws + WS_SSQQ), (float*)(ws + WS_SSQKV)};
            pg8::gemm_phase(lds, g, S, E);
        }
        STAMP(2);
        unsigned* pcnt = (unsigned*)(ws + WS_CTL) + 512;
        LAS int* ubox = (LAS int*)(lds + LDS_BYTES - 16);
        bool all_in = false;
        for (;;) {
            if (tid == 0) *ubox = (int)atomicAdd(ctr2, 1u);
            __syncthreads();
            const int q = __builtin_amdgcn_readfirstlane(*ubox);
            __syncthreads();
            if (!all_in) {
                if (tid == 0) {
                    int fl = 1;
                    if (__hip_atomic_load(cnt1, __ATOMIC_RELAXED, __HIP_MEMORY_SCOPE_AGENT) < 256u) {
                        fl = 0;
                        int kind, p0, p1; unsigned need;
                        if (q < 8) { kind = 3; p0 = 16 * (q & 3); p1 = p0 + 16 < 31 ? p0 + 16 : 31; need = 2u; }
                        else if (q < 200) { kind = 0; p0 = p1 = (q - 8) & 31; need = 2u; }
                        else if (q < 456) { kind = 1; p0 = p1 = (q - 200) & 31; need = 1u; }
                        else if (q < 712) { kind = 2; p0 = p1 = (q - 456) >> 3; need = 1u; }
                        else { kind = 0; p0 = 0; p1 = -1; need = 0u; }
                        unsigned sp = 0;
                        for (int p = p0; p <= p1; ++p)
                            while (__hip_atomic_load(pcnt + (kind * 32 + p) * 4, __ATOMIC_RELAXED, __HIP_MEMORY_SCOPE_AGENT) < need) { __builtin_amdgcn_s_sleep(4); if (++sp > (1u << 22)) break; }
                    }
                    __builtin_amdgcn_fence(__ATOMIC_ACQUIRE, "agent"); asm volatile("s_waitcnt vmcnt(0)" ::: "memory");
                    ubox[1] = fl;
                }
                __syncthreads();
                all_in = __builtin_amdgcn_readfirstlane(ubox[1]) != 0;
                __syncthreads();
            }
            if (q >= 8 + 192 + 256 + 256) break;
            if (q >= 8 && q < 200) { const int v = q - 8;
                pg8::Gemm g{(const bf16_t*)(ws + WS_CQ), (const bf16_t*)(ws + WS_WUQ), QRANK, QRANK, QRANK};
                pg8::OneUnit S{Unit{v & 31, v >> 5, 0}};
                EpiQ E{0, (bf16_t*)(ws + WS_QM), (const float*)(ws + WS_SSQQ), (const float*)(ws + WS_COS), (const float*)(ws + WS_SIN)};
                pg8::gemm_phase(lds, g, S, E);
            } else if (q >= 200 && q < 456) { const int v = q - 200;
                pg8::Gemm g{(const bf16_t*)(ws + WS_CKV), (const bf16_t*)(ws + WS_WUKV), KVRANK, KVRANK, KVRANK};
                pg8::OneUnit S{Unit{v & 31, v >> 5, 0}};
                EpiKV E{0, (bf16_t*)(ws + WS_KM), (bf16_t*)(ws + WS_VM), (const float*)(ws + WS_SSQKV)};
                pg8::gemm_phase(lds, g, S, E);
            } else if (q < 8) { const int kv = q >> 2;
                pg8::Gemm g{(const bf16_t*)(ws + WS_KVC) + (size_t)kv * 2 * T * 64, (const bf16_t*)(ws + (kv ? WS_W1V : WS_W1K)), 1024, 2048, 2048};
                pg8::OneUnit S{Unit{q & 3, 0, 0}};
                EpiPart E{0, (float*)(ws + WS_PARTH) + (size_t)kv * 8 * 1024 * 256};
                pg8::gemm_phase(lds, g, S, E);
            } else { const int ch = q - 456;
                const float* KR = (const float*)(ws + WS_KR); const float* COS = (const float*)(ws + WS_COS); const float* SIN = (const float*)(ws + WS_SIN);
                bf16_t* KM = (bf16_t*)(ws + WS_KM);
                for (int i = ch * 1024 + tid; i < (ch + 1) * 1024; i += 512) { const int t = i >> 5, j = i & 31;
                    const float x1 = KR[(size_t)t * 64 + j], x2 = KR[(size_t)t * 64 + 32 + j], c = COS[i], sn = SIN[i];
                    const unsigned w = pk2(x1 * c - x2 * sn, x2 * c + x1 * sn);
#pragma unroll
                    for (int h = 0; h < 8; ++h) *(unsigned*)(KM + (size_t)t * 1536 + h * 192 + 128 + 2 * j) = w; }
            }
        }
    }
    xcd_barrier(bar); STAMP(3);
    {
        LAS float* HL = (LAS float*)lds;
        LAS float* PR = (LAS float*)(lds + 8192);
        for (int pc = blockIdx.x; pc < 256; pc += G) {
            const int kv = pc >> 7, row0 = (pc & 127) * 8;
            const float* w2 = kv ? P.cmp_w2_v : P.cmp_w2_k;
            float wv[32];
#pragma unroll
            for (int j = 0; j < 32; ++j) wv[j] = w2[(32 * wave + j) * 64 + lane];
            { const int r = tid >> 6, k4 = (tid & 63) * 4;
              const float* part = (const float*)(ws + WS_PARTH) + (size_t)kv * 8 * 1024 * 256 + (size_t)(row0 + r) * 256 + k4;
              f32x4 a = *(const f32x4*)((const float*)(ws + WS_B1) + kv * 256 + k4);
              a += *(const f32x4*)part;
#pragma unroll
              for (int j = 0; j < 4; ++j) HL[r * 256 + k4 + j] = gelu_tanh(a[j]); }
            __syncthreads();
#pragma unroll
            for (int r = 0; r < 8; ++r) { float acc = 0.f;
#pragma unroll
                for (int j4 = 0; j4 < 8; ++j4) { const f32x4 h = *(const LAS f32x4*)(HL + r * 256 + 32 * wave + 4 * j4);
                    acc += h[0] * wv[4 * j4]; acc += h[1] * wv[4 * j4 + 1]; acc += h[2] * wv[4 * j4 + 2]; acc += h[3] * wv[4 * j4 + 3]; }
                PR[(wave * 8 + r) * 64 + lane] = acc; }
            __syncthreads();
            { const int r = tid >> 6, col = tid & 63, row = row0 + r;
              float sacc = 0.f;
              if ((row & 511) != 511) {
#pragma unroll
                  for (int w = 0; w < 8; ++w) sacc += PR[(w * 8 + r) * 64 + col]; }
              ((bf16_t*)(ws + (kv ? WS_VC : WS_KC)))[(size_t)row * 64 + col] = (bf16_t)(pk2(sacc, 0.f) & 0xffffu); }
            __syncthreads();
        }
        asm volatile("s_waitcnt vmcnt(0)" ::: "memory");
        __syncthreads();
        if (tid == 0) { __builtin_amdgcn_fence(__ATOMIC_RELEASE, "agent"); asm volatile("s_waitcnt vmcnt(0)" ::: "memory");
            __hip_atomic_fetch_add((unsigned*)(ws + WS_CTL) + 320, 1u, __ATOMIC_RELAXED, __HIP_MEMORY_SCOPE_AGENT); }
    }
    STAMP(4);
    {
        unsigned* ctr = (unsigned*)(ws + WS_CTL);
        LAS int* ubox = (LAS int*)(lds + LDS_BYTES - 16);
        for (;;) {
            if (tid == 0) *ubox = (int)atomicAdd(ctr, 1u);
            __syncthreads();
            const int u = __builtin_amdgcn_readfirstlane(*ubox);
            __syncthreads();
            if (u >= g_mla_table.n + CONV_UNITS) break;
            if (u < 4 * CONV_UNITS && (u & 3) == 3) { conv_unit(P, lds, u >> 2); continue; }
            const int mi = u < 4 * CONV_UNITS ? u - ((u + 1) >> 2) : u - CONV_UNITS;
            const int uu = g_mla_table.u[mi];
            mla_unit(P, lds, uu & 15, uu >> 8, (uu >> 4) & 15);
        }
#ifdef PROBE
        if (tid == 0) atomicMax(&TS[5], (unsigned long long)__builtin_amdgcn_s_memrealtime());
#endif
        if (tid == 0) { unsigned sp = 0;
            while (__hip_atomic_load((unsigned*)(ws + WS_CTL) + 320, __ATOMIC_RELAXED, __HIP_MEMORY_SCOPE_AGENT) < (unsigned)G) { __builtin_amdgcn_s_sleep(4); if (++sp > (1u << 22)) break; }
            __builtin_amdgcn_fence(__ATOMIC_ACQUIRE, "agent"); asm volatile("s_waitcnt vmcnt(0)" ::: "memory"); }
        __syncthreads();
        for (;;) {
            if (tid == 0) *ubox = (int)atomicAdd(ctr + 64, 1u);
            __syncthreads();
            const int v = __builtin_amdgcn_readfirstlane(*ubox);
            __syncthreads();
            if (v >= 512) break;
            nsa_unit(P, lds, 255 - (v >> 1), v & 1);
        }
    }
    xcd_barrier(bar); STAMP(6);
    {
        const float* SSQN = (const float*)(ws + WS_SSQN); bf16_t* Y = (bf16_t*)(ws + WS_XN);
#pragma unroll 4
        for (int row = blockIdx.x * 8 + wave; row < T; row += G * 8) {
            const int qb = row >> 8, nch = mla_nch(qb), rl = row & 255;
            float y[16];
            if (nch == 1) {
                const u32x4 w0 = *((const u32x4*)(Y + (size_t)row * DM) + 2 * lane), w1 = *((const u32x4*)(Y + (size_t)row * DM) + 2 * lane + 1);
#pragma unroll
                for (int e = 0; e < 4; ++e) { y[2 * e] = __uint_as_float(w0[e] << 16); y[2 * e + 1] = __uint_as_float(w0[e] & 0xffff0000u);
                                              y[8 + 2 * e] = __uint_as_float(w1[e] << 16); y[8 + 2 * e + 1] = __uint_as_float(w1[e] & 0xffff0000u); }
            } else {
                const int h = lane >> 3, dv = 16 * (lane & 7);
                float mm[3], ll[3]; float mx = NEGBIG;
#pragma unroll
                for (int c = 0; c < 3; ++c) if (c < nch) {
                    const unsigned char* pp = (const unsigned char*)P.out + (size_t)((mla_pbase(qb) + c) * 8 + h) * MLA_PART_BYTES;
                    const f32x2 ml = *(const f32x2*)(pp + 256 * 128 * 2 + rl * 8); mm[c] = ml[0]; ll[c] = ml[1]; mx = fmaxf(mx, ml[0]); } else { mm[c] = NEGBIG; ll[c] = 0.f; }
                float lsum = 0.f;
#pragma unroll
                for (int e = 0; e < 16; ++e) y[e] = 0.f;
#pragma unroll
                for (int c = 0; c < 3; ++c) if (c < nch) {
                    const unsigned char* pp = (const unsigned char*)P.out + (size_t)((mla_pbase(qb) + c) * 8 + h) * MLA_PART_BYTES;
                    const float w = __builtin_amdgcn_exp2f(mm[c] - mx); lsum += w * ll[c];
                    const u32x4* po = (const u32x4*)(pp + ((size_t)rl * 128 + dv) * 2);
#pragma unroll
                    for (int e = 0; e < 2; ++e) { const u32x4 v = po[e];
#pragma unroll
                        for (int k = 0; k < 4; ++k) { y[8 * e + 2 * k] += w * __uint_as_float(v[k] << 16); y[8 * e + 2 * k + 1] += w * __uint_as_float(v[k] & 0xffff0000u); } } }
                const float il = 1.f / lsum;
#pragma unroll
                for (int e = 0; e < 16; ++e) y[e] *= il;
            }
            float ss = 0.f;
#pragma unroll
            for (int e = 0; e < 16; ++e) ss += y[e] * y[e];
            const f32x2 cn = *(const f32x2*)(SSQN + (size_t)row * 2);
            const float rm = rsqrtf(wave_sum(ss) * (1.f / 1024.f) + EPS) * sqrtf((cn[0] + cn[1]) * (1.f / 1024.f) + EPS);
            u32x4 w0, w1;
#pragma unroll
            for (int e = 0; e < 4; ++e) { w0[e] = pk2(y[2 * e] * rm, y[2 * e + 1] * rm); w1[e] = pk2(y[8 + 2 * e] * rm, y[8 + 2 * e + 1] * rm); }
            *((u32x4*)(Y + (size_t)row * DM) + 2 * lane) = w0; *((u32x4*)(Y + (size_t)row * DM) + 2 * lane + 1) = w1;
        }
    }
    xcd_barrier(bar); STAMP(7);
    {
        pg8::Gemm g{(const bf16_t*)(ws + WS_XN), (const bf16_t*)(ws + WS_WO), DM, DM, DM};
        pg8::Order S; S.init(T / 256, DM / 256, G, blockIdx.x);
        EpiO E{0, P.x, P.out, (float*)(ws + WS_SSQ2), (bf16_t*)(ws + WS_HB), (const float*)(ws + WS_SSQN)};
        pg8::gemm_phase(lds, g, S, E);
    }
    xcd_barrier(bar); STAMP(8);
    {
        pg8::Gemm g{(const bf16_t*)(ws + WS_HB), (const bf16_t*)(ws + WS_WUP), DM, DM, DM};
        pg8::Order S; S.init(T / 256, MLPH / 256, G, blockIdx.x);
        LAS float* R2T = (LAS float*)(lds + 131072);
        if (tid < 256) { const int row = (blockIdx.x & 31) * 256 + tid; R2T[tid] = rsqrtf(sum32((const float*)(ws + WS_SSQ2) + (size_t)row * 32) * (1.f / 2048.f) + EPS); }
        __syncthreads();
        EpiUp E{0, R2T, (bf16_t*)(ws + WS_U)};
        pg8::gemm_phase(lds, g, S, E);
    }
    xcd_barrier(bar); STAMP(9);
    if (G == (T / 256) * (DM / 256)) {
        pg8::Gemm g{(const bf16_t*)(ws + WS_U), (const bf16_t*)(ws + WS_WDN), MLPH, MLPH, MLPH};
        pg8::Order S; S.init(T / 256, DM / 256, G, blockIdx.x);
        EpiDownNorm E{0, (const bf16_t*)(ws + WS_HB), P.out, (float*)(ws + WS_SSQ3), (unsigned*)(ws + WS_CTL) + 2048, P.final_norm_w, (LAS float*)(lds + 131072)};
        pg8::gemm_phase(lds, g, S, E);
        STAMP(10);
    } else {
        {
            pg8::Gemm g{(const bf16_t*)(ws + WS_U), (const bf16_t*)(ws + WS_WDN), MLPH, MLPH, MLPH};
            pg8::Order S; S.init(T / 256, DM / 256, G, blockIdx.x);
            EpiDown E{0, (const bf16_t*)(ws + WS_HB), P.out, (float*)(ws + WS_SSQ3)};
            pg8::gemm_phase(lds, g, S, E);
        }
        xcd_barrier(bar);
        const float* SSQ3 = (const float*)(ws + WS_SSQ3);
        for (int row = blockIdx.x * 8 + wave; row < T; row += G * 8) {
            const float r = rsqrtf(sum32(SSQ3 + (size_t)row * 32) * (1.f / DM) + EPS);
            f32x4* o = (f32x4*)(P.out + (size_t)row * DM) + lane;
#pragma unroll
            for (int j = 0; j < 8; ++j) { const f32x4 w = *((const f32x4*)P.final_norm_w + lane + 64 * j); o[64 * j] = o[64 * j] * r * w; }
        }
    }
#ifdef PROBE
    xcd_barrier(bar); STAMP(11);
    if (blockIdx.x == 0) {
        __syncthreads();
        const float a = (float)(TS[PROBE_A + 1] - TS[PROBE_A]) * 0.01f, b = (float)(TS[PROBE_B + 1] - TS[PROBE_B]) * 0.01f;
        if (tid == 0) P.out[2000000] += a * 0.05f;
        for (int i = tid; i < 1000000; i += 512) P.out[i] += b * 0.0005f;
    }
#endif
}

extern "C" void kernel_launch(void* const* d_in, const int* in_sizes, int n_in, void* d_out, int out_size, void* d_ws, size_t ws_size, hipStream_t stream) {
    static int grid = 0;
    if (grid == 0) {
        if (n_in != 21 || out_size != T * DM || ws_size < WS_END) { fprintf(stderr, "kernel_launch: unexpected shapes (n_in %d out %d ws %zu)\n", n_in, out_size, ws_size); grid = -1; return; }
        int dev = 0, cus = 0, per_cu = 0;
        hipGetDevice(&dev);
        hipDeviceGetAttribute(&cus, hipDeviceAttributeMultiprocessorCount, dev);
        hipFuncSetAttribute((const void*)mega_fwd, hipFuncAttributeMaxDynamicSharedMemorySize, LDS_BYTES);
        hipOccupancyMaxActiveBlocksPerMultiprocessor(&per_cu, (const void*)mega_fwd, 512, LDS_BYTES);
        if (per_cu < 1) { fprintf(stderr, "kernel_launch: occupancy query reports %d blocks per CU\n", per_cu); per_cu = 1; }
        (void)hipGetLastError();
        grid = cus;
        if (grid != 256) { fprintf(stderr, "kernel_launch: built for 256 CUs (one workgroup per CU), device reports %d\n", grid); grid = -1; return; }
    }
    if (grid < 0) return;
    hipMemsetAsync((char*)d_ws + WS_CTL, 0, 65536, stream);
    Params p{};
    p.x = (const float*)d_in[0]; p.positions = (const int*)d_in[1]; p.attn_norm_w = (const float*)d_in[2]; p.w_in = (const float*)d_in[3];
    p.mla_q_norm_w = (const float*)d_in[4]; p.mla_w_uq = (const float*)d_in[5]; p.mla_kv_norm_w = (const float*)d_in[6]; p.mla_w_ukv = (const float*)d_in[7];
    p.cmp_pos_k = (const float*)d_in[8]; p.cmp_pos_v = (const float*)d_in[9]; p.cmp_w1_k = (const float*)d_in[10]; p.cmp_w2_k = (const float*)d_in[11];
    p.cmp_w1_v = (const float*)d_in[12]; p.cmp_w2_v = (const float*)d_in[13]; p.mla_out_norm_w = (const float*)d_in[14]; p.nsa_out_norm_w = (const float*)d_in[15];
    p.w_o = (const float*)d_in[16]; p.mlp_norm_w = (const float*)d_in[17]; p.w_up = (const float*)d_in[18]; p.w_down = (const float*)d_in[19]; p.final_norm_w = (const float*)d_in[20];
    p.out = (float*)d_out; p.ws = (unsigned char*)d_ws;
    void* args[] = {&p};
    hipError_t e = hipLaunchCooperativeKernel((const void*)mega_fwd, dim3(grid), dim3(512), args, LDS_BYTES, stream);
    if (e != hipSuccess) fprintf(stderr, "cooperative launch failed: %s (grid %d)\n", hipGetErrorString(e), grid);
}
```
